# Optimizing an MI355X kernel written in HIP

```python
import jax, jax.numpy as jnp
from jax import lax
import numpy as np

D_MODEL = 1024
BATCH = 2
SEQ = 8192
DEPTH = 1

CHUNK = 64
Q_BLOCK = 128
SB_HEAD_DIM = 64
SB_HEADS = (D_MODEL // 2) // SB_HEAD_DIM
SB_WIDTH = SB_HEADS * SB_HEAD_DIM
GLA_HEADS = 4
GLA_DV = (D_MODEL // 2) // GLA_HEADS
GLA_DK = GLA_DV // 2
GLA_VWIDTH = GLA_HEADS * GLA_DV
GLA_KWIDTH = GLA_HEADS * GLA_DK
GLA_GATE_RANK = 16
GLA_TAU = 16.0
MIX_WIDTH = SB_WIDTH + GLA_VWIDTH
D_FF = 2816
CONV_WIDTH = 3
N_MOD = 6
EPS = 1e-6
IN_SPLITS = (SB_WIDTH, SB_WIDTH, SB_WIDTH,
             GLA_KWIDTH, GLA_KWIDTH, GLA_VWIDTH,
             GLA_VWIDTH, GLA_GATE_RANK)
IN_WIDTH = sum(IN_SPLITS)

kernel_name = "hybrid_stickbreak_gla_convffn_adaln"


def rms_norm(x, gain):
    xf = x.astype(jnp.float32)
    n = xf * lax.rsqrt(jnp.mean(xf * xf, axis=-1, keepdims=True) + EPS)
    return (n * gain.astype(jnp.float32)).astype(x.dtype)


def modulate(h, shift, scale):
    return h * (1 + scale[:, None, :]) + shift[:, None, :]


def stick_breaking_attention(q, k, v):
    B, S, H, d = q.shape
    q = q.transpose(0, 2, 1, 3)
    k = k.transpose(0, 2, 1, 3)
    v = v.transpose(0, 2, 1, 3)
    scale = d ** -0.5
    outs = []
    for i in range(S // Q_BLOCK):
        start = i * Q_BLOCK
        end = start + Q_BLOCK
        qb = q[:, :, start:end]
        kb = k[:, :, :end]
        vb = v[:, :, :end]
        z = jnp.einsum('bhqd,bhkd->bhqk', qb, kb).astype(jnp.float32) * scale
        t_pos = start + jnp.arange(Q_BLOCK)
        s_pos = jnp.arange(end)
        mask = s_pos[None, :] < t_pos[:, None]
        log_one_minus = jnp.where(mask, jax.nn.log_sigmoid(-z), 0.0)
        shifted = jnp.concatenate(
            [log_one_minus[..., 1:], jnp.zeros_like(log_one_minus[..., :1])], axis=-1)
        between = lax.cumsum(shifted, axis=3, reverse=True)
        weights = jnp.where(mask, jnp.exp(jax.nn.log_sigmoid(z) + between), 0.0)
        outs.append(jnp.einsum('bhqk,bhkd->bhqd', weights.astype(vb.dtype), vb))
    o = jnp.concatenate(outs, axis=2)
    return o.transpose(0, 2, 1, 3).reshape(B, S, H * d)


def gla_chunk_causal(q, k, v, log_alpha):
    B, S, H, dk = q.shape
    dv = v.shape[-1]
    nc = S // CHUNK
    qc = q.reshape(B, nc, CHUNK, H, dk).astype(jnp.float32) * (dk ** -0.5)
    kc = k.reshape(B, nc, CHUNK, H, dk).astype(jnp.float32)
    vc = v.reshape(B, nc, CHUNK, H, dv).astype(jnp.float32)
    la = log_alpha.reshape(B, nc, CHUNK, H, dk).astype(jnp.float32)
    cum = jnp.cumsum(la, axis=2)
    total = cum[:, :, -1]
    k_dec = kc * jnp.exp(total[:, :, None] - cum)
    chunk_kv = jnp.einsum('bnchk,bnchv->nbhkv', k_dec, vc)
    chunk_decay = jnp.exp(total).transpose(1, 0, 2, 3)

    def step(state, inp):
        decay, kv = inp
        state = decay[..., None] * state + kv
        return state, state

    s0 = jnp.zeros((B, H, dk, dv), jnp.float32)
    _, states = lax.scan(step, s0, (chunk_decay, chunk_kv))
    o = jnp.einsum('bnchk,nbhkv->bnchv', qc, states)
    return o.reshape(B, S, H * dv)


def causal_depthwise_conv(u, w, b):
    S = u.shape[1]
    up = jnp.pad(u, ((0, 0), (CONV_WIDTH - 1, 0), (0, 0)))
    out = b
    for j in range(CONV_WIDTH):
        out = out + w[j] * up[:, j:j + S]
    return out


def setup_inputs(seed: int = 0) -> dict:
    key = jax.random.key(seed)
    ks = jax.random.split(key, 18)

    def nrm(k, shape, scale):
        return jax.random.normal(k, shape, jnp.float32) * scale

    L, D = DEPTH, D_MODEL
    return {
        "x": nrm(ks[0], (BATCH, SEQ, D), 1.0),
        "c": nrm(ks[1], (BATCH, D), 1.0),
        "w_ada": nrm(ks[2], (L, D, N_MOD * D), 0.5 * D ** -0.5),
        "b_ada": nrm(ks[3], (L, N_MOD * D), 0.01),
        "g_norm1": 1.0 + nrm(ks[4], (L, D), 0.02),
        "w_in": nrm(ks[5], (L, D, IN_WIDTH), D ** -0.5),
        "w_fg2": nrm(ks[6], (L, GLA_GATE_RANK, GLA_KWIDTH), GLA_GATE_RANK ** -0.5),
        "b_fg2": nrm(ks[7], (L, GLA_KWIDTH), 0.1),
        "g_gla_out": 1.0 + nrm(ks[8], (L, GLA_VWIDTH), 0.02),
        "w_out": nrm(ks[9], (L, MIX_WIDTH, D), MIX_WIDTH ** -0.5),
        "g_norm2": 1.0 + nrm(ks[10], (L, D), 0.02),
        "w_up": nrm(ks[11], (L, D, 2 * D_FF), D ** -0.5),
        "w_conv": nrm(ks[12], (L, CONV_WIDTH, 2 * D_FF), CONV_WIDTH ** -0.5),
        "b_conv": nrm(ks[13], (L, 2 * D_FF), 0.01),
        "w_down": nrm(ks[14], (L, D_FF, D), D_FF ** -0.5),
        "g_final": 1.0 + nrm(ks[15], (D,), 0.02),
    }


def reference(x, c, w_ada, b_ada, g_norm1, w_in, w_fg2, b_fg2, g_gla_out, w_out,
              g_norm2, w_up, w_conv, b_conv, w_down, g_final):
    B, S, _ = x.shape
    offsets = np.cumsum(IN_SPLITS)[:-1].tolist()
    for l in range(DEPTH):
        mod = jax.nn.silu(c) @ w_ada[l] + b_ada[l]
        shift1, scale1, gate1, shift2, scale2, gate2 = jnp.split(mod, N_MOD, axis=-1)

        h = modulate(rms_norm(x, g_norm1[l]), shift1, scale1)
        proj = h @ w_in[l]
        sb_q, sb_k, sb_v, gq, gk, gv, gg, gf = jnp.split(proj, offsets, axis=-1)

        o_sb = stick_breaking_attention(
            sb_q.reshape(B, S, SB_HEADS, SB_HEAD_DIM),
            sb_k.reshape(B, S, SB_HEADS, SB_HEAD_DIM),
            sb_v.reshape(B, S, SB_HEADS, SB_HEAD_DIM))

        log_alpha = jax.nn.log_sigmoid(
            (gf @ w_fg2[l] + b_fg2[l]).astype(jnp.float32)) / GLA_TAU
        o_gla = gla_chunk_causal(
            gq.reshape(B, S, GLA_HEADS, GLA_DK),
            gk.reshape(B, S, GLA_HEADS, GLA_DK),
            gv.reshape(B, S, GLA_HEADS, GLA_DV),
            log_alpha.reshape(B, S, GLA_HEADS, GLA_DK))
        oh = o_gla.reshape(B, S, GLA_HEADS, GLA_DV)
        oh = oh * lax.rsqrt(jnp.mean(oh * oh, axis=-1, keepdims=True) + EPS)
        o_gla = (oh.reshape(B, S, GLA_VWIDTH) * g_gla_out[l].astype(jnp.float32)
                 ).astype(x.dtype) * jax.nn.silu(gg)

        mixed = jnp.concatenate([o_sb.astype(x.dtype), o_gla], axis=-1) @ w_out[l]
        x = x + (1 + gate1[:, None, :]) * mixed

        h2 = modulate(rms_norm(x, g_norm2[l]), shift2, scale2)
        u = causal_depthwise_conv(h2 @ w_up[l], w_conv[l], b_conv[l])
        val, gte = jnp.split(u, 2, axis=-1)
        x = x + (1 + gate2[:, None, :]) * ((val * jax.nn.silu(gte)) @ w_down[l])
    return rms_norm(x, g_final)
```

```cpp
#include <hip/hip_runtime.h>
#include <hip/hip_cooperative_groups.h>
#include <cstdio>
#include <cstdint>
namespace cg = cooperative_groups;

#define LAS __attribute__((address_space(3)))
typedef unsigned short bf16_t;
typedef short bf16x8 __attribute__((ext_vector_type(8)));
typedef float f32x4 __attribute__((ext_vector_type(4)));
typedef float f32x16 __attribute__((ext_vector_type(16)));
typedef unsigned u32x4 __attribute__((ext_vector_type(4)));
typedef unsigned u32x2 __attribute__((ext_vector_type(2)));
typedef float f32x2_t __attribute__((ext_vector_type(2)));
typedef __bf16 bf16x2_t __attribute__((ext_vector_type(2)));

constexpr int SEQ = 8192, M = 16384, D = 1024, FF = 2816, FF2 = 5632, INW = 3088, NMOD = 6144;
constexpr int NA = 1792;
constexpr int NTR = 1280;
constexpr float EPS = 1e-6f;
constexpr float LOG2E = 1.4426950408889634f;

constexpr size_t MiB = 1u << 20;
constexpr size_t WS_MOD = 0;
constexpr size_t WS_BAR = 64 * 1024;
constexpr size_t WS_CTL_BYTES = 64 * 1024;
constexpr size_t WS_BAR2 = WS_BAR + 49 * 1024;
constexpr size_t WS_CNT0 = WS_BAR + 16 * 1024, WS_CNT1 = WS_BAR + 32 * 1024;
constexpr size_t WS_PART0 = 128 * 1024, WS_PART1 = 384 * 1024;
constexpr size_t WS_WDOWN = 1 * MiB;
constexpr size_t WS_WINM = 13 * MiB;
constexpr size_t WS_WINT = 17 * MiB;
constexpr size_t WS_WOUT = 20 * MiB;
constexpr size_t WS_WUP = 22 * MiB;
constexpr size_t WS_DEC = 33 * MiB;
constexpr size_t WS_GF = 33 * MiB + 512 * 1024;
constexpr size_t WS_WGF = 640 * 1024;
constexpr size_t WS_H = 34 * MiB;
constexpr size_t WS_MIX = 66 * MiB;
constexpr size_t WS_SQ = 98 * MiB;
constexpr size_t WS_SK = 114 * MiB;
constexpr size_t WS_SV = 130 * MiB;
constexpr size_t WS_GQ = 146 * MiB;
constexpr size_t WS_GG = 154 * MiB;
constexpr size_t WS_GK = 170 * MiB;
constexpr size_t WS_GV = 178 * MiB;
constexpr size_t WS_KV = 202 * MiB;
constexpr size_t WS_S = 234 * MiB;
constexpr size_t WS_A = 66 * MiB;
constexpr size_t WS_HALO = 160 * MiB;
constexpr size_t WS_HEAD = 168 * MiB;
constexpr size_t WS_END = 256 * MiB;

constexpr int LDS_BYTES = 147456;

__device__ __forceinline__ unsigned cvtpk(float lo, float hi) { f32x2_t v = {lo, hi}; bf16x2_t b = __builtin_convertvector(v, bf16x2_t); return __builtin_bit_cast(unsigned, b); }
__device__ __forceinline__ float bflo(unsigned w) { return __uint_as_float(w << 16); }
__device__ __forceinline__ float bfhi(unsigned w) { return __uint_as_float(w & 0xffff0000u); }
__device__ __forceinline__ float wave_sum(float v) {
#pragma unroll
    for (int o = 1; o < 64; o <<= 1) v += __shfl_xor(v, o);
    return v;
}
#define MFMA32(a, b, c) __builtin_amdgcn_mfma_f32_32x32x16_bf16((a), (b), (c), 0, 0, 0)
template <int CTRL, bool BC> __device__ __forceinline__ float dppf(float old, float src) {
    return __builtin_bit_cast(float, __builtin_amdgcn_update_dpp(__builtin_bit_cast(int, old), __builtin_bit_cast(int, src), CTRL, 0xf, 0xf, BC));
}

namespace pg8 {
constexpr int BM = 256, BK = 64, HALF = 128, HTB = HALF * BK * 2, STAGE_BYTES = 8 * HTB, NXCD = 8, WGM = 8;
__device__ __forceinline__ int lds_byte(int r, int c) { const int st = (r >> 4) * 2 + (c >> 5), rr = r & 15, cc = c & 31, ob = rr * 64 + cc * 2; return st * 1024 + (ob ^ (((ob >> 9) & 1) << 5)); }
__device__ __forceinline__ void stage_rc(int b, int& R, int& C) { const int st = b / 1024, sb = b % 1024, swz = sb ^ (((sb >> 9) & 1) << 5); R = (st >> 1) * 16 + swz / 64; C = (st & 1) * 32 + (swz % 64) / 2; }
__device__ __forceinline__ int perm32(int rho) { const int n = rho >> 4, i = rho & 15; return 8 * (i >> 2) + 4 * n + (i & 3); }

struct Unit { int pm, pn, kind; };

struct Sched2 {
    const char *A0, *B0, *A1, *B1; size_t tsA0, tsB0, tsA1, tsB1; int nM0, nN0, n0, nM1, nN1, n1, G, c;
    __device__ __forceinline__ static void map(int wgid, int nwg, int nM, int nN, Unit& u) {
        { const int q = nwg / NXCD, r = nwg % NXCD, xcd = wgid % NXCD, off = wgid / NXCD; wgid = (xcd < r ? xcd * (q + 1) : r * (q + 1) + (xcd - r) * q) + off; }
        const int nig = WGM * nN, gid = wgid / nig, fm = gid * WGM, gsz = (nM - fm) < WGM ? (nM - fm) : WGM;
        u.pm = fm + ((wgid % nig) % gsz); u.pn = (wgid % nig) / gsz;
    }
    __device__ __forceinline__ bool next(int i, Unit& u) const {
        const long L = (long)i * G + c; if (L >= n0 + n1) return false;
        if (L < n0) { map((int)L, n0, nM0, nN0, u); u.kind = 0; } else { map((int)L - n0, n1, nM1, nN1, u); u.kind = 1; }
        return true;
    }
    __device__ __forceinline__ const char* baseA(const Unit& u) const { return u.kind ? A1 + (size_t)u.pm * tsA1 : A0 + (size_t)u.pm * tsA0; }
    __device__ __forceinline__ const char* baseB(const Unit& u) const { return u.kind ? B1 + (size_t)u.pn * tsB1 : B0 + (size_t)u.pn * tsB0; }
};

template <class Epi, class Sched, bool ALIGN_EPI>
__device__ __forceinline__ void gemm_phase(LAS unsigned char* lds, const int K, const int lda, const Sched& S, const Epi& E) {
    int tid_ = threadIdx.x; asm volatile("" : "+v"(tid_));
    const int tid = tid_, wid = __builtin_amdgcn_readfirstlane(tid >> 6), lane = tid & 63, wr = wid >> 2, wc = wid & 3, fr = lane & 15, fq = lane >> 4;
    const int nt = K / BK;
    unsigned voffA[2], voffB[2];
#pragma unroll
    for (int i = 0; i < 2; ++i) { int R, C; stage_rc(tid * 16 + i * 8192, R, C); const int Rb = Epi::PERM ? ((R & ~31) + perm32(R & 31)) : R;
        const int Ra = Epi::APERM ? ((R & 64) + 4 * (R & 15) + ((R & 63) >> 4)) : R;
        voffA[i] = (unsigned)(Ra * lda + C) * 2u; voffB[i] = (unsigned)(Rb * K + C) * 2u; }
    const size_t kstep = (size_t)(BK * 2);
    const size_t hsA = (size_t)HALF * lda * 2, hsB = (size_t)HALF * K * 2;
    const unsigned ldsw = (unsigned)wid * 1024u;
    const int aoff = lds_byte(wr * 64 + fr, fq * 8), boff = lds_byte(wc * 32 + fr, fq * 8);
#define PG8_SA(b, h) (((b) * 2 + (h)) * HTB)
#define PG8_SB(b, h) ((4 + (b) * 2 + (h)) * HTB)
#define PG8_STAGE(bufoff, gbase, voff) do { _Pragma("unroll") for (int _i = 0; _i < 2; ++_i) \
        __builtin_amdgcn_global_load_lds((const unsigned*)((const char*)(gbase) + (voff)[_i]), (LAS unsigned*)(lds + (bufoff) + ldsw + _i * 8192), 16, 0, 0); } while (0)
#define PG8_LDA(dst, b, h) do { _Pragma("unroll") for (int m = 0; m < 4; ++m) _Pragma("unroll") for (int k = 0; k < 2; ++k) dst[m][k] = *(const LAS bf16x8*)(lds + PG8_SA(b, h) + aoff + m * 2048 + k * 1024); } while (0)
#define PG8_LDB(dst, b, h) do { _Pragma("unroll") for (int n = 0; n < 2; ++n) _Pragma("unroll") for (int k = 0; k < 2; ++k) dst[n][k] = *(const LAS bf16x8*)(lds + PG8_SB(b, h) + boff + n * 2048 + k * 1024); } while (0)
#define PG8_MMA(ai, bj, At, Bt) do { __builtin_amdgcn_s_setprio(1); _Pragma("unroll") for (int m = 0; m < 4; ++m) _Pragma("unroll") for (int n = 0; n < 2; ++n) _Pragma("unroll") for (int k = 0; k < 2; ++k) \
        acc[ai][bj][m][n] = __builtin_amdgcn_mfma_f32_16x16x32_bf16(Bt[n][k], At[m][k], acc[ai][bj][m][n], 0, 0, 0); __builtin_amdgcn_s_setprio(0); } while (0)
#define PG8_WAIT_V(n) asm volatile("s_waitcnt vmcnt(" #n ")" ::: "memory")
#define PG8_WAIT_L(n) asm volatile("s_waitcnt lgkmcnt(" #n ")" ::: "memory")
#define PG8_BAR __builtin_amdgcn_s_barrier()
#define PG8_SCHED __builtin_amdgcn_sched_barrier(0)
    Unit cur, nxt; int ui = 0;
    if (!S.next(0, cur)) return;
    f32x4 acc[2][2][4][2];
#pragma unroll
    for (int a = 0; a < 2; ++a)
#pragma unroll
        for (int b = 0; b < 2; ++b)
#pragma unroll
            for (int m = 0; m < 4; ++m)
#pragma unroll
                for (int n = 0; n < 2; ++n) acc[a][b][m][n] = (f32x4){0.f, 0.f, 0.f, 0.f};
    bf16x8 At[4][2], B0[2][2], B1[2][2];
    const char* cA = S.baseA(cur); const char* cB = S.baseB(cur);
    PG8_STAGE(PG8_SB(0, 0), cB, voffB); PG8_STAGE(PG8_SB(0, 1), cB + hsB, voffB); PG8_STAGE(PG8_SA(0, 0), cA, voffA); PG8_STAGE(PG8_SA(0, 1), cA + hsA, voffA);
    if (wr == 1) PG8_BAR;
    PG8_WAIT_V(2); PG8_BAR;
    PG8_STAGE(PG8_SB(1, 0), cB + kstep, voffB); PG8_STAGE(PG8_SA(1, 0), cA + kstep, voffA); PG8_STAGE(PG8_SB(1, 1), cB + hsB + kstep, voffB);
    PG8_WAIT_V(6); PG8_BAR;
    for (;;) {
        const bool has_next = S.next(ui + 1, nxt);
        const char* nA = has_next ? S.baseA(nxt) : cA; const char* nB = has_next ? S.baseB(nxt) : cB;
        for (int t = 0; t < nt; t += 2) {
            const bool last = (t == nt - 2);
            const char* a1 = cA + (size_t)(t + 1) * kstep;
            const char* a2 = last ? nA : cA + (size_t)(t + 2) * kstep; const char* b2 = last ? nB : cB + (size_t)(t + 2) * kstep;
            const char* a3 = a2 + kstep; const char* b3 = b2 + kstep;
            PG8_LDB(B0, 0, 0); PG8_LDB(B1, 0, 1); PG8_SCHED; PG8_LDA(At, 0, 0); PG8_STAGE(PG8_SA(1, 1), a1 + hsA, voffA);
            PG8_WAIT_V(8); PG8_WAIT_L(0); PG8_BAR; PG8_MMA(0, 0, At, B0); PG8_MMA(0, 1, At, B1); PG8_BAR; PG8_SCHED;
            PG8_LDA(At, 0, 1); PG8_STAGE(PG8_SB(0, 0), b2, voffB); PG8_STAGE(PG8_SB(0, 1), b2 + hsB, voffB); PG8_STAGE(PG8_SA(0, 0), a2, voffA);
            PG8_WAIT_V(8); PG8_WAIT_L(0); PG8_BAR; PG8_MMA(1, 0, At, B0); PG8_MMA(1, 1, At, B1); PG8_BAR; PG8_SCHED;
            PG8_LDB(B0, 1, 0); PG8_LDB(B1, 1, 1); PG8_SCHED; PG8_LDA(At, 1, 0); PG8_STAGE(PG8_SA(0, 1), a2 + hsA, voffA);
            PG8_WAIT_V(8); PG8_WAIT_L(0); PG8_BAR; PG8_MMA(0, 0, At, B0); PG8_MMA(0, 1, At, B1); PG8_BAR; PG8_SCHED;
            PG8_LDA(At, 1, 1); PG8_STAGE(PG8_SB(1, 0), b3, voffB); PG8_STAGE(PG8_SB(1, 1), b3 + hsB, voffB); PG8_STAGE(PG8_SA(1, 0), a3, voffA);
            PG8_WAIT_V(8); PG8_WAIT_L(0); PG8_BAR; PG8_MMA(1, 0, At, B0); PG8_MMA(1, 1, At, B1); PG8_BAR; PG8_SCHED;
        }
        if constexpr (ALIGN_EPI) { if (wr == 0) PG8_BAR; }
        E(acc, cur, wr, wc, fr, fq);
        if (!has_next) break;
#pragma unroll
        for (int a = 0; a < 2; ++a)
#pragma unroll
            for (int b = 0; b < 2; ++b)
#pragma unroll
                for (int m = 0; m < 4; ++m)
#pragma unroll
                    for (int n = 0; n < 2; ++n) acc[a][b][m][n] = (f32x4){0.f, 0.f, 0.f, 0.f};
        cur = nxt; cA = nA; cB = nB; ++ui;
        if constexpr (ALIGN_EPI) { if (wr == 1) PG8_BAR; }
    }
    PG8_WAIT_V(0);
    if constexpr (!ALIGN_EPI) { if (wr == 0) PG8_BAR; }
    PG8_BAR;
#undef PG8_SA
#undef PG8_SB
#undef PG8_STAGE
#undef PG8_LDA
#undef PG8_LDB
#undef PG8_MMA
#undef PG8_WAIT_V
#undef PG8_WAIT_L
#undef PG8_BAR
#undef PG8_SCHED
}

struct EpiProj {
    static constexpr bool PERM = true, APERM = false;
    bf16_t *SQ, *SK, *SV, *GQ, *GG, *GK, *GV;
    __device__ __forceinline__ void operator()(const f32x4 (&acc)[2][2][4][2], const Unit& u, int wr, int wc, int fr, int fq) const {
        const int row0 = u.pm * BM + wr * 64 + fr, col0 = u.pn * BM + wc * 32 + 8 * fq;
#pragma unroll
        for (int ai = 0; ai < 2; ++ai)
#pragma unroll
            for (int m = 0; m < 4; ++m) {
                const int row = row0 + ai * HALF + m * 16;
#pragma unroll
                for (int bj = 0; bj < 2; ++bj) {
                    const int col = col0 + bj * HALF;
                    f32x4 v0 = acc[ai][bj][m][0], v1 = acc[ai][bj][m][1];
                    if (u.kind == 0 && u.pn < 2) { v0 = v0 * (0.125f * LOG2E); v1 = v1 * (0.125f * LOG2E); }
                    u32x4 w; w.x = cvtpk(v0[0], v0[1]); w.y = cvtpk(v0[2], v0[3]); w.z = cvtpk(v1[0], v1[1]); w.w = cvtpk(v1[2], v1[3]);
                    bf16_t* dst;
                    if (u.kind == 0) {
                        const int b = row >> 13, t = row & 8191;
                        if (u.pn < 2)       dst = SQ + ((size_t)((b * 8 + (col >> 6)) * SEQ + t) * 64 + (col & 63));
                        else if (u.pn < 4)  { const int c2 = col - 512;  dst = SK + ((size_t)((b * 8 + (c2 >> 6)) * SEQ + t) * 64 + (c2 & 63)); }
                        else if (u.pn < 5)  { const int c2 = col - 1024; dst = GQ + ((size_t)((b * 4 + (c2 >> 6)) * SEQ + t) * 64 + (c2 & 63)); }
                        else                { const int c2 = col - 1280; dst = GG + ((size_t)((b * 4 + (c2 >> 7)) * SEQ + t) * 128 + (c2 & 127)); }
                    } else {
                        const int b = col >> 13, t = col & 8191;
                        if (u.pm < 2)       dst = SV + ((size_t)(((b * 8 + (row >> 6)) * 256 + (t >> 5)) * 64 + (row & 63)) * 32 + (t & 31));
                        else if (u.pm < 4)  { const int f2 = row - 512;  dst = GV + ((size_t)(((b * 4 + (f2 >> 7)) * 128 + (t >> 6)) * 128 + (f2 & 127)) * 64 + (t & 63)); }
                        else                { const int f2 = row - 1024; dst = GK + ((size_t)(((b * 4 + (f2 >> 6)) * 128 + (t >> 6)) * 64 + (f2 & 63)) * 64 + (t & 63)); }
                    }
                    *(u32x4*)dst = w;
                }
            }
    }
};
struct EpiUpConv {
    static constexpr bool PERM = true, APERM = true;
    bf16_t* A; bf16_t* halo; bf16_t* head; const float* w_conv; const float* b_conv;
    __device__ __forceinline__ void operator()(f32x4 (&acc)[2][2][4][2], const Unit& u, int wr, int wc, int fr, int fq) const {
        const int row0 = u.pm * BM + wr * 64 + 4 * fr;
        const int cl = wc * 32 + 8 * fq;
        const int f0 = u.pn * HALF + cl;
        if (fr == 15 || fr == 0) {
#pragma unroll
            for (int ai = 0; ai < 2; ++ai)
#pragma unroll
                for (int bj = 0; bj < 2; ++bj)
#pragma unroll
                    for (int q = 0; q < 2; ++q) {
                        const int m = (fr == 15) ? 2 + q : q;
                        const f32x4 v0 = (fr == 15) ? acc[ai][bj][2 + q][0] : acc[ai][bj][q][0], v1 = (fr == 15) ? acc[ai][bj][2 + q][1] : acc[ai][bj][q][1];
                        u32x4 w; w.x = cvtpk(v0[0], v0[1]); w.y = cvtpk(v0[2], v0[3]); w.z = cvtpk(v1[0], v1[1]); w.w = cvtpk(v1[2], v1[3]);
                        bf16_t* side = (fr == 15) ? halo : head;
                        *(u32x4*)(side + ((size_t)((row0 + ai * HALF + m) >> 6) * 2 + q) * FF2 + u.pn * BM + bj * HALF + cl) = w;
                    }
        }
#pragma unroll
        for (int n = 0; n < 2; ++n)
#pragma unroll
            for (int bj = 0; bj < 2; ++bj) {
                const int fc = bj * FF + f0 + 4 * n;
                const f32x4 w0 = *(const f32x4*)(w_conv + fc), w1 = *(const f32x4*)(w_conv + FF2 + fc), w2 = *(const f32x4*)(w_conv + 2 * FF2 + fc), bb = *(const f32x4*)(b_conv + fc);
#pragma unroll
                for (int ai = 0; ai < 2; ++ai) {
                    const f32x4 r0 = acc[ai][bj][0][n], r1 = acc[ai][bj][1][n], r2 = acc[ai][bj][2][n], r3 = acc[ai][bj][3][n];
                    f32x4 s3, s2;
#pragma unroll
                    for (int j = 0; j < 4; ++j) { s3[j] = dppf<0x111, true>(0.f, r3[j]); s2[j] = dppf<0x111, true>(0.f, r2[j]); }
                    acc[ai][bj][3][n] = bb + w0 * r1 + w1 * r2 + w2 * r3;
                    acc[ai][bj][2][n] = bb + w0 * r0 + w1 * r1 + w2 * r2;
                    acc[ai][bj][1][n] = bb + w0 * s3 + w1 * r0 + w2 * r1;
                    acc[ai][bj][0][n] = bb + w0 * s2 + w1 * s3 + w2 * r0;
                }
            }
#pragma unroll
        for (int ai = 0; ai < 2; ++ai)
#pragma unroll
            for (int m = 0; m < 4; ++m) {
                const int row = row0 + ai * HALF + m;
                float o[8];
#pragma unroll
                for (int n = 0; n < 2; ++n)
#pragma unroll
                    for (int j = 0; j < 4; ++j) { const float v = acc[ai][0][m][n][j], g = acc[ai][1][m][n][j]; o[4 * n + j] = v * (g * __builtin_amdgcn_rcpf(1.0f + __expf(-g))); }
                u32x4 w; w.x = cvtpk(o[0], o[1]); w.y = cvtpk(o[2], o[3]); w.z = cvtpk(o[4], o[5]); w.w = cvtpk(o[6], o[7]);
                *(u32x4*)(A + (size_t)row * FF + f0) = w;
            }
    }
};

template <int MODE> struct EpiResNorm {
    static constexpr bool PERM = false, APERM = false;
    const float* base; float* out; const float* gate; const float* gain; const float* scale; const float* shift; bf16_t* hb; float* part; unsigned* cnt; LAS unsigned char* xl;
    __device__ __forceinline__ void operator()(f32x4 (&acc)[2][2][4][2], const Unit& u, int wr, int wc, int fr, int fq) const {
        int tid = threadIdx.x; asm volatile("" : "+v"(tid));
        LAS float* P = (LAS float*)xl;
        LAS float* S = (LAS float*)(xl + 4096);
        const int rl0 = wr * 64 + fr, col0 = u.pn * BM + wc * 32 + 4 * fq, bb = u.pm >> 5;
        const int rbase = (u.pm * BM + rl0) * D + col0;
        const float* gp = gate + (size_t)bb * NMOD;
        f32x4 rb0[8], rb1[8];
#define RN_LOAD(g, dst) do { _Pragma("unroll") for (int ai = 0; ai < 2; ++ai) _Pragma("unroll") for (int m = 0; m < 4; ++m) { \
            int off = rbase; asm volatile("" : "+v"(off)); off += (ai * HALF + m * 16) * D + ((g) >> 1) * HALF + ((g) & 1) * 16; \
            dst[ai * 4 + m] = __builtin_nontemporal_load((const f32x4*)(base + off)); } } while (0)
#define RN_USE(g, src) do { const f32x4 gv = *(const f32x4*)(gp + col0 + ((g) >> 1) * HALF + ((g) & 1) * 16) + 1.0f; \
            _Pragma("unroll") for (int ai = 0; ai < 2; ++ai) _Pragma("unroll") for (int m = 0; m < 4; ++m) acc[ai][(g) >> 1][m][(g) & 1] = src[ai * 4 + m] + gv * acc[ai][(g) >> 1][m][(g) & 1]; \
            asm volatile("" : "+v"(acc[0][(g) >> 1][0][(g) & 1]), "+v"(acc[0][(g) >> 1][1][(g) & 1]), "+v"(acc[0][(g) >> 1][2][(g) & 1]), "+v"(acc[0][(g) >> 1][3][(g) & 1]), \
                               "+v"(acc[1][(g) >> 1][0][(g) & 1]), "+v"(acc[1][(g) >> 1][1][(g) & 1]), "+v"(acc[1][(g) >> 1][2][(g) & 1]), "+v"(acc[1][(g) >> 1][3][(g) & 1]) :: "memory"); } while (0)
        RN_LOAD(0, rb0); RN_LOAD(1, rb1);
        RN_USE(0, rb0);  RN_LOAD(2, rb0);
        RN_USE(1, rb1);  RN_LOAD(3, rb1);
        RN_USE(2, rb0);  RN_USE(3, rb1);
#undef RN_LOAD
#undef RN_USE
#pragma unroll
        for (int ai = 0; ai < 2; ++ai)
#pragma unroll
            for (int m = 0; m < 4; ++m) {
                float sq = 0.f;
#pragma unroll
                for (int bj = 0; bj < 2; ++bj)
#pragma unroll
                    for (int n = 0; n < 2; ++n) { const f32x4 v = acc[ai][bj][m][n]; sq += (v.x * v.x + v.y * v.y) + (v.z * v.z + v.w * v.w); }
                sq += __shfl_xor(sq, 16); sq += __shfl_xor(sq, 32);
                if (fq == 0) P[(ai * HALF + rl0 + m * 16) * 4 + wc] = sq;
            }
        asm volatile("s_waitcnt lgkmcnt(0)" ::: "memory"); __builtin_amdgcn_s_barrier(); asm volatile("" ::: "memory");
        if (tid < 256) {
            const float tot = (P[tid * 4 + 0] + P[tid * 4 + 1]) + (P[tid * 4 + 2] + P[tid * 4 + 3]);
            __hip_atomic_store(part + ((size_t)(u.pm * 4 + u.pn) * 256 + tid), tot, __ATOMIC_RELAXED, __HIP_MEMORY_SCOPE_AGENT);
        }
        asm volatile("s_waitcnt vmcnt(0) lgkmcnt(0)" ::: "memory"); __builtin_amdgcn_s_barrier(); asm volatile("" ::: "memory");
        if (tid == 0) {
            unsigned* cw = cnt + 64 * u.pm;
            __hip_atomic_fetch_add(cw, 1u, __ATOMIC_RELAXED, __HIP_MEMORY_SCOPE_AGENT);
            unsigned sp = 0u;
            while (__hip_atomic_load(cw, __ATOMIC_RELAXED, __HIP_MEMORY_SCOPE_AGENT) < 4u) { __builtin_amdgcn_s_sleep(1); if (++sp > (1u << 22)) break; }
            __builtin_amdgcn_fence(__ATOMIC_ACQUIRE, "agent");
        }
        asm volatile("s_waitcnt vmcnt(0) lgkmcnt(0)" ::: "memory"); __builtin_amdgcn_s_barrier(); asm volatile("" ::: "memory");
        if (tid < 256) {
            float t = 0.f;
#pragma unroll
            for (int j = 0; j < 4; ++j) t += __hip_atomic_load(part + ((size_t)(u.pm * 4 + j) * 256 + tid), __ATOMIC_RELAXED, __HIP_MEMORY_SCOPE_AGENT);
            S[tid] = 1.0f / sqrtf(t * (1.0f / D) + EPS);
        }
        asm volatile("s_waitcnt vmcnt(0) lgkmcnt(0)" ::: "memory"); __builtin_amdgcn_s_barrier(); asm volatile("" ::: "memory");
#pragma unroll
        for (int bj = 0; bj < 2; ++bj)
#pragma unroll
            for (int n = 0; n < 2; ++n) {
                const int c = col0 + bj * HALF + n * 16;
                const f32x4 gn = *(const f32x4*)(gain + c);
                f32x4 sc1 = {0.f, 0.f, 0.f, 0.f}, sh = {0.f, 0.f, 0.f, 0.f};
                if (MODE == 0) { sc1 = *(const f32x4*)(scale + (size_t)bb * NMOD + c) + 1.0f; sh = *(const f32x4*)(shift + (size_t)bb * NMOD + c); }
#pragma unroll
                for (int ai = 0; ai < 2; ++ai)
#pragma unroll
                    for (int m = 0; m < 4; ++m) {
                        const int rl = ai * HALF + rl0 + m * 16;
                        int off = rbase; asm volatile("" : "+v"(off));
                        off += (ai * HALF + m * 16) * D + bj * HALF + n * 16;
                        const float r = S[rl];
                        const f32x4 v = acc[ai][bj][m][n];
                        if (MODE == 0) {
                            __builtin_nontemporal_store(v, (f32x4*)(out + off));
                            const f32x4 h = (v * r * gn) * sc1 + sh;
                            u32x2 w; w.x = cvtpk(h.x, h.y); w.y = cvtpk(h.z, h.w);
                            *(u32x2*)(hb + off) = w;
                        } else {
                            __builtin_nontemporal_store(v * r * gn, (f32x4*)(out + off));
                        }
                        asm volatile("" ::: "memory");
                    }
            }
    }
};
}

#define XB_TMO      128
#define XB_XCNT(j)  (256  + 64 * (j))
#define XB_XSUB(j)  (1280 + 64 * (j))
#define XB_XGEN(j)  (2304 + 64 * (j))
#define XB_TOP      3328
#define XB_TOPGEN   3392
#define XCD_BAR_WORDS 3456
#define XB_SPIN_CAP (1u << 18)
__device__ __forceinline__ unsigned xb_ld(unsigned* p)              { return __hip_atomic_load(p, __ATOMIC_RELAXED, __HIP_MEMORY_SCOPE_AGENT); }
__device__ __forceinline__ unsigned xb_add(unsigned* p, unsigned v) { return __hip_atomic_fetch_add(p, v, __ATOMIC_RELAXED, __HIP_MEMORY_SCOPE_AGENT); }
__device__ __forceinline__ unsigned xb_xcc_id() { return (unsigned)__builtin_amdgcn_s_getreg((3 << 11) | 20) & 0xFu; }
#define XB_SPIN(cond, bar) do { unsigned _sp = 0; while (cond) { __builtin_amdgcn_s_sleep(1); \
    if ((++_sp & 255u) == 0u) { if (xb_ld(&(bar)[XB_TMO])) break; if (_sp > XB_SPIN_CAP) { atomicAdd(&(bar)[XB_TMO], 1u); break; } } } } while (0)
struct XcdBarrier { unsigned* bar; unsigned x; volatile LAS unsigned* st; };
__device__ __forceinline__ XcdBarrier xcd_barrier_post(unsigned* bar, volatile LAS unsigned* st) {
    XcdBarrier b; b.bar = bar; b.x = xb_xcc_id(); b.st = st;
    if (threadIdx.x == 0) (void)xb_add(&bar[XB_XCNT(b.x)], 1u);
    return b;
}
__device__ __forceinline__ void xcd_barrier_complete(unsigned* bar, unsigned x, unsigned& nloc, unsigned& nx) {
    const unsigned G = gridDim.x * gridDim.y * gridDim.z;
    unsigned sum, cnt, mine, sp = 0u;
    for (;;) {
        sum = 0u; cnt = 0u; mine = 0u;
#pragma unroll
        for (unsigned j = 0; j < 16; ++j) { const unsigned c = xb_ld(&bar[XB_XCNT(j)]); sum += c; cnt += (c > 0u) ? 1u : 0u; mine = (j == x) ? c : mine; }
        if (sum == G) break;
        __builtin_amdgcn_s_sleep(1);
        if ((++sp & 255u) == 0u) { if (xb_ld(&bar[XB_TMO])) break; if (sp > XB_SPIN_CAP) { atomicAdd(&bar[XB_TMO], 1u); break; } }
    }
    nloc = mine > 0u ? mine : 1u; nx = cnt > 0u ? cnt : 1u;
}
__device__ __forceinline__ void xcd_barrier(const XcdBarrier& b) {
    asm volatile("s_waitcnt vmcnt(0)" ::: "memory");
    __syncthreads();
    if (threadIdx.x == 0) {
        unsigned* bar = b.bar;
        __builtin_amdgcn_s_waitcnt(0);
        unsigned nloc = b.st[0], nx = b.st[1];
        if (nloc == 0u) { xcd_barrier_complete(bar, b.x, nloc, nx); b.st[0] = nloc; b.st[1] = nx; }
        const unsigned old = xb_add(&bar[XB_XSUB(b.x)], 1u);
        const unsigned gen = old / nloc;
        if (old + 1u == (gen + 1u) * nloc) {
            __builtin_amdgcn_fence(__ATOMIC_RELEASE, "agent");
            asm volatile("s_waitcnt vmcnt(0)" ::: "memory");
            const unsigned og = xb_add(&bar[XB_TOP], 1u);
            const unsigned tg = og / nx;
            if (og + 1u == (tg + 1u) * nx) xb_add(&bar[XB_TOPGEN], 1u);
            else XB_SPIN(xb_ld(&bar[XB_TOPGEN]) == tg, bar);
            __builtin_amdgcn_fence(__ATOMIC_ACQUIRE, "agent");
            xb_add(&bar[XB_XGEN(b.x)], 1u);
            asm volatile("s_waitcnt vmcnt(0)" ::: "memory");
        } else {
            XB_SPIN(xb_ld(&bar[XB_XGEN(b.x)]) == gen, bar);
            __builtin_amdgcn_fence(__ATOMIC_ACQUIRE, "agent");
            asm volatile("s_waitcnt vmcnt(0)" ::: "memory");
        }
    }
    __syncthreads();
}

__device__ __forceinline__ void xcd_barrier_sub4(const XcdBarrier& b, volatile LAS unsigned* lw, unsigned round, int wave, int lane) {
    asm volatile("s_waitcnt vmcnt(0) lgkmcnt(0)" ::: "memory");
    if (lane == 0) {
        __hip_atomic_fetch_add((LAS unsigned*)&lw[0], 1u, __ATOMIC_RELAXED, __HIP_MEMORY_SCOPE_WORKGROUP);
        if (wave == 0) {
            { unsigned sp = 0u; while (lw[0] < 4u * round) { __builtin_amdgcn_s_sleep(1); if (++sp > (1u << 24)) break; } }
            unsigned* bar = b.bar;
            __builtin_amdgcn_s_waitcnt(0);
            unsigned nloc = b.st[0], nx = b.st[1];
            if (nloc == 0u) { xcd_barrier_complete(bar, b.x, nloc, nx); b.st[0] = nloc; b.st[1] = nx; }
            const unsigned old = xb_add(&bar[XB_XSUB(b.x)], 1u);
            const unsigned gen = old / nloc;
            if (old + 1u == (gen + 1u) * nloc) {
                __builtin_amdgcn_fence(__ATOMIC_RELEASE, "agent");
                asm volatile("s_waitcnt vmcnt(0)" ::: "memory");
                const unsigned og = xb_add(&bar[XB_TOP], 1u);
                const unsigned tg = og / nx;
                if (og + 1u == (tg + 1u) * nx) xb_add(&bar[XB_TOPGEN], 1u);
                else XB_SPIN(xb_ld(&bar[XB_TOPGEN]) == tg, bar);
                __builtin_amdgcn_fence(__ATOMIC_ACQUIRE, "agent");
                xb_add(&bar[XB_XGEN(b.x)], 1u);
                asm volatile("s_waitcnt vmcnt(0)" ::: "memory");
            } else {
                XB_SPIN(xb_ld(&bar[XB_XGEN(b.x)]) == gen, bar);
                __builtin_amdgcn_fence(__ATOMIC_ACQUIRE, "agent");
                asm volatile("s_waitcnt vmcnt(0)" ::: "memory");
            }
            lw[1] = round;
            asm volatile("s_waitcnt lgkmcnt(0)" ::: "memory");
        } else {
            unsigned sp = 0u; while (lw[1] < round) { __builtin_amdgcn_s_sleep(2); if (++sp > (1u << 24)) break; }
        }
    }
    asm volatile("" ::: "memory");
}

struct Params {
    const float *x, *c, *w_ada, *b_ada, *g1, *w_in, *w_fg2, *b_fg2, *g_gla, *w_out, *g2, *w_up, *w_conv, *b_conv, *w_down, *g_final;
    float* out; unsigned char* ws;
};

struct TrDesc { const float* W; int ld, c0; bf16_t* WT; int Kd, r0, kb, nb; };
__device__ __forceinline__ void tr_load(const TrDesc& d, float (&tv)[32], int lane) {
    const int k0 = 64 * d.kb, n0 = 32 * d.nb;
#pragma unroll
    for (int i = 0; i < 32; ++i) tv[i] = __builtin_nontemporal_load(d.W + (size_t)(k0 + 2 * i + (lane >> 5)) * d.ld + d.c0 + n0 + (lane & 31));
}
__device__ __forceinline__ void tr_store(const TrDesc& d, const float (&tv)[32], float* scr, int lane) {
    const int k0 = 64 * d.kb, n0 = 32 * d.nb;
#pragma unroll
    for (int i = 0; i < 32; ++i) scr[(2 * i + (lane >> 5)) * 33 + (lane & 31)] = tv[i];
    asm volatile("s_waitcnt lgkmcnt(0)" ::: "memory");
    const int c = lane & 7;
#pragma unroll
    for (int j = 0; j < 4; ++j) { const int n = (lane >> 3) + 8 * j; const float* sp = scr + (8 * c) * 33 + n;
        u32x4 o; o.x = cvtpk(sp[0 * 33], sp[1 * 33]); o.y = cvtpk(sp[2 * 33], sp[3 * 33]); o.z = cvtpk(sp[4 * 33], sp[5 * 33]); o.w = cvtpk(sp[6 * 33], sp[7 * 33]);
        *(u32x4*)(d.WT + (size_t)(d.r0 + n0 + n) * d.Kd + k0 + 8 * c) = o; }
    asm volatile("s_waitcnt lgkmcnt(0)" ::: "memory");
}
__device__ __forceinline__ void tr_item(const float* W, int ld, int c0, bf16_t* WT, int Kd, int r0, float* scr, int kb, int nb, int lane) {
    const TrDesc d{W, ld, c0, WT, Kd, r0, kb, nb};
    float tv[32];
    tr_load(d, tv, lane);
    tr_store(d, tv, scr, lane);
}

__device__ __forceinline__ void norm_mod_rows(const float* X, const float* gain, const float* shift, const float* scale, bf16_t* H, int gw, int NGW, int lane) {
    for (int m0 = gw; m0 < M; m0 += 4 * NGW) {
        f32x4 v[4][4];
#pragma unroll
        for (int q = 0; q < 4; ++q) {
            const int m = m0 + q * NGW;
            const f32x4* xr = (const f32x4*)(X + (size_t)(m < M ? m : m0) * D) + lane;
#pragma unroll
            for (int j = 0; j < 4; ++j) v[q][j] = __builtin_nontemporal_load(xr + 64 * j);
        }
#pragma unroll
        for (int q = 0; q < 4; ++q) {
            const int m = m0 + q * NGW;
            if (m >= M) break;
            const int b = m >> 13;
            float ss = 0.f;
#pragma unroll
            for (int j = 0; j < 4; ++j) ss += (v[q][j].x * v[q][j].x + v[q][j].y * v[q][j].y) + (v[q][j].z * v[q][j].z + v[q][j].w * v[q][j].w);
            const float r = 1.0f / sqrtf(wave_sum(ss) * (1.0f / D) + EPS);
            unsigned long long* o8 = (unsigned long long*)(H + (size_t)m * D) + lane;
#pragma unroll
            for (int j = 0; j < 4; ++j) {
                const f32x4 g = ((const f32x4*)gain)[64 * j + lane], sc = ((const f32x4*)(scale + (size_t)b * NMOD))[64 * j + lane], sh = ((const f32x4*)(shift + (size_t)b * NMOD))[64 * j + lane];
                const f32x4 o = (v[q][j] * r * g) * (sc + 1.0f) + sh;
                o8[64 * j] = (unsigned long long)cvtpk(o.x, o.y) | ((unsigned long long)cvtpk(o.z, o.w) << 32);
            }
        }
    }
}

__device__ __forceinline__ int crow(int r, int hi) { return (r & 3) + 8 * (r >> 2) + 4 * hi; }

__device__ __forceinline__ void sb_unit(const bf16_t* SQ, const bf16_t* SK, const bf16_t* SV, bf16_t* MIX, int b, int h, int qi, int lane, LAS unsigned char* lbuf) {
    const int r = lane & 31, hh = lane >> 5;
    const int pr = (r & 0x13) | ((r & 4) << 1) | ((r & 8) >> 1);
    const size_t tq = (size_t)b * SEQ + (size_t)qi * 32;
    bf16x8 qf[4];
#pragma unroll
    for (int d0 = 0; d0 < 4; ++d0) qf[d0] = *(const bf16x8*)(SQ + ((size_t)(b * 8 + h) * SEQ + (size_t)qi * 32 + r) * 64 + 16 * d0 + 8 * hh);
    f32x16 o0, o1;
#pragma unroll
    for (int i = 0; i < 16; ++i) { o0[i] = 0.f; o1[i] = 0.f; }
    float R = 0.f;
    const bf16_t* kbase = SK + ((size_t)(b * 8 + h) * SEQ + pr) * 64 + 8 * hh;
    const bf16_t* vbase = SV + ((size_t)(b * 8 + h) * 256 * 64 + r) * 32 + 8 * hh;
    LAS unsigned char* wbuf = lbuf + 16 * lane;
    int cur = 0;
#define SB_DMA(kt_, bufsel) do { const int k0_ = (kt_) * 32; LAS unsigned char* d_ = lbuf + (bufsel) * 8192; \
        _Pragma("unroll") for (int d0 = 0; d0 < 4; ++d0) __builtin_amdgcn_global_load_lds((const unsigned*)(kbase + (size_t)k0_ * 64 + 16 * d0), (LAS unsigned*)(d_ + d0 * 1024), 16, 0, 0); \
        _Pragma("unroll") for (int db = 0; db < 2; ++db) _Pragma("unroll") for (int s = 0; s < 2; ++s) \
            __builtin_amdgcn_global_load_lds((const unsigned*)(vbase + (size_t)k0_ * 64 + (32 * db) * 32 + 16 * s), (LAS unsigned*)(d_ + (4 + 2 * db + s) * 1024), 16, 0, 0); } while (0)
    SB_DMA(qi, 0);
    for (int kt = qi; ; --kt) {
        bf16x8 kf[4], vf[2][2];
        asm volatile("s_waitcnt vmcnt(0)" ::: "memory");
        { LAS unsigned char* rb = wbuf + cur * 8192;
#pragma unroll
          for (int d0 = 0; d0 < 4; ++d0) kf[d0] = *(const LAS bf16x8*)(rb + d0 * 1024);
#pragma unroll
          for (int db = 0; db < 2; ++db)
#pragma unroll
              for (int s = 0; s < 2; ++s) vf[db][s] = *(const LAS bf16x8*)(rb + (4 + 2 * db + s) * 1024); }
        asm volatile("s_waitcnt lgkmcnt(0)" ::: "memory");
        SB_DMA((kt > 0 ? kt - 1 : 0), cur ^ 1);
        cur ^= 1;
        f32x16 acc;
#pragma unroll
        for (int i = 0; i < 16; ++i) acc[i] = 0.f;
#pragma unroll
        for (int d0 = 0; d0 < 4; ++d0) acc = MFMA32(kf[d0], qf[d0], acc);
        const bool diag = (kt == qi);
        float w[16];
        float mx = fmaxf(acc[0], acc[1]);
#pragma unroll
        for (int i = 2; i < 16; ++i) mx = fmaxf(mx, acc[i]);
        if (!__any(mx > 15.0f)) {
            float t[16], pi[16];
#pragma unroll
            for (int i = 0; i < 16; ++i) {
                const int kl = 16 * (i >> 3) + 8 * hh + (i & 7);
                const float tv = __builtin_amdgcn_exp2f(acc[i]);
                t[i] = (diag && !(kl < r)) ? 0.f : tv;
            }
            pi[7] = 1.0f + t[7]; pi[15] = 1.0f + t[15];
#pragma unroll
            for (int i = 6; i >= 0; --i) { pi[i] = fmaf(t[i], pi[i + 1], pi[i + 1]); pi[8 + i] = fmaf(t[8 + i], pi[9 + i], pi[9 + i]); }
            const float G0 = -__builtin_amdgcn_logf(pi[0]), G1 = -__builtin_amdgcn_logf(pi[8]);
            const float P0 = __shfl_xor(G0, 32), P1 = __shfl_xor(G1, 32);
            const float F1 = __builtin_amdgcn_exp2f(R + (hh == 0 ? P1 : 0.f));
            const float F0 = __builtin_amdgcn_exp2f(R + G1 + P1 + (hh == 0 ? P0 : 0.f));
#pragma unroll
            for (int i = 0; i < 8; ++i) { w[i] = (t[i] * F0) * __builtin_amdgcn_rcpf(pi[i]); w[8 + i] = (t[8 + i] * F1) * __builtin_amdgcn_rcpf(pi[8 + i]); }
            R += (G0 + P0) + (G1 + P1);
        } else {
            float l[16], e[16];
#pragma unroll
            for (int i = 0; i < 16; ++i) {
                const int kl = 16 * (i >> 3) + 8 * hh + (i & 7);
                const float zz = acc[i];
                const float sp = fmaxf(zz, 0.f) + __builtin_amdgcn_logf(1.0f + __builtin_amdgcn_exp2f(-fabsf(zz)));
                const bool valid = (!diag) || (kl < r);
                l[i] = valid ? -sp : 0.f;
                e[i] = valid ? (zz - sp) : -1.0e30f;
            }
            float G0 = 0.f, G1 = 0.f;
#pragma unroll
            for (int i = 0; i < 8; ++i) { G0 += l[i]; G1 += l[8 + i]; }
            const float P0 = __shfl_xor(G0, 32), P1 = __shfl_xor(G1, 32);
            const float base1 = R + (hh == 0 ? P1 : 0.f);
            const float base0 = R + G1 + P1 + (hh == 0 ? P0 : 0.f);
            { float run = 0.f;
#pragma unroll
              for (int i = 7; i >= 0; --i) { w[i] = __builtin_amdgcn_exp2f(e[i] + base0 + run); run += l[i]; } }
            { float run = 0.f;
#pragma unroll
              for (int i = 7; i >= 0; --i) { w[8 + i] = __builtin_amdgcn_exp2f(e[8 + i] + base1 + run); run += l[8 + i]; } }
            R += (G0 + P0) + (G1 + P1);
        }
        u32x4 p0, p1;
        p0.x = cvtpk(w[0], w[1]); p0.y = cvtpk(w[2], w[3]); p0.z = cvtpk(w[4], w[5]); p0.w = cvtpk(w[6], w[7]);
        p1.x = cvtpk(w[8], w[9]); p1.y = cvtpk(w[10], w[11]); p1.z = cvtpk(w[12], w[13]); p1.w = cvtpk(w[14], w[15]);
        const bf16x8 pf0 = __builtin_bit_cast(bf16x8, p0), pf1 = __builtin_bit_cast(bf16x8, p1);
        o0 = MFMA32(vf[0][0], pf0, o0); o0 = MFMA32(vf[0][1], pf1, o0);
        o1 = MFMA32(vf[1][0], pf0, o1); o1 = MFMA32(vf[1][1], pf1, o1);
        if (kt == 0 || __all(R < -151.0f)) break;
    }
#undef SB_DMA
    bf16_t* op = MIX + (tq + r) * D + h * 64 + 4 * hh;
#pragma unroll
    for (int g = 0; g < 4; ++g) {
        u32x2 a; a.x = cvtpk(o0[4 * g], o0[4 * g + 1]); a.y = cvtpk(o0[4 * g + 2], o0[4 * g + 3]);
        u32x2 c; c.x = cvtpk(o1[4 * g], o1[4 * g + 1]); c.y = cvtpk(o1[4 * g + 2], o1[4 * g + 3]);
        *(u32x2*)(op + 8 * g) = a; *(u32x2*)(op + 32 + 8 * g) = c;
    }
}

__device__ __forceinline__ void gla_a_unit(const bf16_t* GK, const bf16_t* GV, const bf16_t* GF, const float* w_fg2, const float* b_fg2, float* KV, float* DEC, int w, int lane) {
    const int jh = w & 1, h = (w >> 1) & 3, n = (w >> 3) & 127, b = w >> 10;
    const int un = (b * 128 + n) * 4 + h;
    const int r = lane & 31, hh = lane >> 5, j = 32 * jh + r;
    const int pr = (r & 0x13) | ((r & 4) << 1) | ((r & 8) >> 1);
    const size_t tb = (size_t)b * SEQ + (size_t)n * 64 + 8 * hh;
    const bf16_t* kp = GK + ((size_t)((b * 4 + h) * 128 + n) * 64 + j) * 64 + 8 * hh;
    const float bias = b_fg2[h * 64 + j];
    f32x16 xa[2];
    { const float* wp = w_fg2 + (size_t)(8 * hh) * 256 + h * 64 + j;
      u32x4 wb; wb.x = cvtpk(wp[0], wp[256]); wb.y = cvtpk(wp[512], wp[768]); wb.z = cvtpk(wp[1024], wp[1280]); wb.w = cvtpk(wp[1536], wp[1792]);
      const bf16x8 wf = __builtin_bit_cast(bf16x8, wb);
      const bf16_t* gfp = GF + ((size_t)b * SEQ + (size_t)n * 64 + pr) * 16 + 8 * hh;
#pragma unroll
      for (int blk = 0; blk < 2; ++blk) {
          const bf16x8 ga = *(const bf16x8*)(gfp + (size_t)(32 * blk) * 16);
#pragma unroll
          for (int i = 0; i < 16; ++i) xa[blk][i] = 0.f;
          xa[blk] = MFMA32(ga, wf, xa[blk]);
      } }
    float la[4][8], kk[4][8];
#pragma unroll
    for (int s = 0; s < 4; ++s) {
        const u32x4 kw = *(const u32x4*)(kp + 16 * s);
#pragma unroll
        for (int q = 0; q < 4; ++q) {
            kk[s][2 * q] = bflo(kw[q]); kk[s][2 * q + 1] = bfhi(kw[q]);
            const float x0 = xa[s >> 1][8 * (s & 1) + 2 * q] + bias, x1 = xa[s >> 1][8 * (s & 1) + 2 * q + 1] + bias;
            la[s][2 * q] = (fminf(x0, 0.f) - __logf(1.0f + __expf(-fabsf(x0)))) * (1.0f / 16.0f);
            la[s][2 * q + 1] = (fminf(x1, 0.f) - __logf(1.0f + __expf(-fabsf(x1)))) * (1.0f / 16.0f);
        }
    }
    float G[4], P[4];
#pragma unroll
    for (int s = 0; s < 4; ++s) { float g = 0.f;
#pragma unroll
        for (int e = 0; e < 8; ++e) g += la[s][e];
        G[s] = g; P[s] = __shfl_xor(g, 32); }
    bf16x8 kd[4];
    float after = 0.f;
#pragma unroll
    for (int s = 3; s >= 0; --s) {
        const float a0 = after + (hh == 0 ? P[s] : 0.f);
        float run = 0.f; float dv[8];
#pragma unroll
        for (int e = 7; e >= 0; --e) { dv[e] = kk[s][e] * __expf(a0 + run); run += la[s][e]; }
        u32x4 pk; pk.x = cvtpk(dv[0], dv[1]); pk.y = cvtpk(dv[2], dv[3]); pk.z = cvtpk(dv[4], dv[5]); pk.w = cvtpk(dv[6], dv[7]);
        kd[s] = __builtin_bit_cast(bf16x8, pk);
        after += G[s] + P[s];
    }
    if (hh == 0) DEC[(size_t)un * 64 + j] = __expf(after);
    const bf16_t* vp = GV + ((size_t)((b * 4 + h) * 128 + n) * 128 + r) * 64 + 8 * hh;
    float* kvo = KV + (size_t)un * 8192 + j;
#pragma unroll
    for (int vb = 0; vb < 4; ++vb) {
        f32x16 acc;
#pragma unroll
        for (int i = 0; i < 16; ++i) acc[i] = 0.f;
#pragma unroll
        for (int s = 0; s < 4; ++s) { const bf16x8 a = *(const bf16x8*)(vp + (size_t)(32 * vb) * 64 + 16 * s); acc = MFMA32(a, kd[s], acc); }
#pragma unroll
        for (int i = 0; i < 16; ++i) kvo[(size_t)(32 * vb + crow(i, hh)) * 64] = acc[i];
    }
}

__device__ __forceinline__ void gla_c_unit(const bf16_t* GQ, const bf16_t* GG, const bf16_t* SB, const float* g_gla, bf16_t* MIX, int w, int lane) {
    const int th = w & 1, h = (w >> 1) & 3, n = (w >> 3) & 127, b = w >> 10;
    const int un = (b * 128 + n) * 4 + h;
    const int r = lane & 31, hh = lane >> 5;
    const size_t tl = (size_t)n * 64 + 32 * th + r, tok = (size_t)b * SEQ + tl;
    bf16x8 qf[4];
#pragma unroll
    for (int ks = 0; ks < 4; ++ks) qf[ks] = *(const bf16x8*)(GQ + ((size_t)(b * 4 + h) * SEQ + tl) * 64 + 16 * ks + 8 * hh);
    const bf16_t* sp = SB + (size_t)un * 8192 + (size_t)r * 64 + 8 * hh;
    const bf16_t* gp = GG + ((size_t)(b * 4 + h) * SEQ + tl) * 128 + 4 * hh;
    u32x2 gwv[4][4];
#pragma unroll
    for (int vb = 0; vb < 4; ++vb)
#pragma unroll
        for (int g = 0; g < 4; ++g) gwv[vb][g] = *(const u32x2*)(gp + 32 * vb + 8 * g);
    __builtin_amdgcn_sched_barrier(0);
    f32x16 acc[4];
    float ss = 0.f;
#pragma unroll
    for (int vb = 0; vb < 4; ++vb) {
#pragma unroll
        for (int i = 0; i < 16; ++i) acc[vb][i] = 0.f;
#pragma unroll
        for (int ks = 0; ks < 4; ++ks) { const bf16x8 a = *(const bf16x8*)(sp + (size_t)(32 * vb) * 64 + 16 * ks); acc[vb] = MFMA32(a, qf[ks], acc[vb]); }
#pragma unroll
        for (int i = 0; i < 16; ++i) { acc[vb][i] *= 0.125f; ss += acc[vb][i] * acc[vb][i]; }
    }
    ss += __shfl_xor(ss, 32);
    const float rinv = __builtin_amdgcn_rsqf(ss * (1.0f / 128.0f) + EPS);
    bf16_t* op = MIX + tok * D + 512 + h * 128 + 4 * hh;
    const float* gg = g_gla + h * 128 + 4 * hh;
#pragma unroll
    for (int vb = 0; vb < 4; ++vb)
#pragma unroll
        for (int g = 0; g < 4; ++g) {
            const int v0 = 32 * vb + 8 * g;
            const u32x2 gw2 = gwv[vb][g];
            const f32x4 gn = *(const f32x4*)(gg + v0);
            float gt[4] = {bflo(gw2.x), bfhi(gw2.x), bflo(gw2.y), bfhi(gw2.y)};
            float ov[4];
#pragma unroll
            for (int q = 0; q < 4; ++q) { const float y = acc[vb][4 * g + q] * rinv * gn[q]; ov[q] = y * (gt[q] * __builtin_amdgcn_rcpf(1.0f + __expf(-gt[q]))); }
            u32x2 st; st.x = cvtpk(ov[0], ov[1]); st.y = cvtpk(ov[2], ov[3]);
            *(u32x2*)(op + v0) = st;
        }
}

__global__ void __launch_bounds__(512, 2) fwd_megakernel(Params p) {
    extern __shared__ __attribute__((aligned(16))) unsigned char lds[];
    cg::grid_group grid = cg::this_grid();
    const int tid = threadIdx.x, lane = tid & 63, wave = __builtin_amdgcn_readfirstlane(tid >> 6);
    const int G = gridDim.x, bid = blockIdx.x;
    const int gw = bid * 8 + wave, NGW = G * 8;
    const int vcu = (G % 8 == 0) ? (bid % 8) * (G / 8) + bid / 8 : bid;
    const int gwx = vcu * 8 + wave;
    const int gtid = bid * 512 + tid, NTH = G * 512;
    unsigned char* ws = p.ws;
    float* MOD = (float*)(ws + WS_MOD);
    bf16_t* WDOWN = (bf16_t*)(ws + WS_WDOWN); bf16_t* HALO = (bf16_t*)(ws + WS_HALO); bf16_t* HEAD = (bf16_t*)(ws + WS_HEAD);
    bf16_t* WINM = (bf16_t*)(ws + WS_WINM); bf16_t* WINT = (bf16_t*)(ws + WS_WINT); bf16_t* WOUT = (bf16_t*)(ws + WS_WOUT); bf16_t* WUP = (bf16_t*)(ws + WS_WUP);
    float* DEC = (float*)(ws + WS_DEC); bf16_t* HB = (bf16_t*)(ws + WS_H); bf16_t* MIX = (bf16_t*)(ws + WS_MIX);
    bf16_t* SQ = (bf16_t*)(ws + WS_SQ); bf16_t* SK = (bf16_t*)(ws + WS_SK); bf16_t* SV = (bf16_t*)(ws + WS_SV); bf16_t* GQB = (bf16_t*)(ws + WS_GQ);
    bf16_t* GGB = (bf16_t*)(ws + WS_GG); bf16_t* GKB = (bf16_t*)(ws + WS_GK); bf16_t* GVB = (bf16_t*)(ws + WS_GV); float* KV = (float*)(ws + WS_KV); bf16_t* SB = (bf16_t*)(ws + WS_S);
    bf16_t* AB = (bf16_t*)(ws + WS_A);
    bf16_t* GF = (bf16_t*)(ws + WS_GF); bf16_t* WGF = (bf16_t*)(ws + WS_WGF);
    LAS unsigned char* ldsl = (LAS unsigned char*)lds;
    unsigned* BARW = (unsigned*)(ws + WS_BAR);
    volatile LAS unsigned* bst = (volatile LAS unsigned*)(ldsl + 131072 + 512);
    if (tid < 8) bst[tid] = 0u;
    const XcdBarrier xbar = xcd_barrier_post(BARW, bst);
    const XcdBarrier xbar2 = xcd_barrier_post((unsigned*)(ws + WS_BAR2), bst + 2);
    if (p.ws == nullptr) grid.sync();

    if (bid < 192) {
        float* sc = (float*)lds; float* red = sc + 2048;
        const int c4 = tid & 7, kg = tid >> 3;
        const f32x4* wp = (const f32x4*)(p.w_ada + bid * 32) + c4;
        f32x4 wv[16];
#pragma unroll
        for (int i = 0; i < 16; ++i) wv[i] = __builtin_nontemporal_load(wp + (size_t)(kg + 64 * i) * (NMOD / 4));
        for (int i = tid; i < 2048; i += 512) { const float v = p.c[i]; sc[i] = v * __builtin_amdgcn_rcpf(1.0f + __expf(-v)); }
        __syncthreads();
        f32x4 a0 = {0.f, 0.f, 0.f, 0.f}, a1 = {0.f, 0.f, 0.f, 0.f};
#pragma unroll
        for (int i = 0; i < 16; ++i) { const int k = kg + 64 * i; a0 += wv[i] * sc[k]; a1 += wv[i] * sc[1024 + k]; }
#pragma unroll
        for (int q = 0; q < 4; ++q) { red[kg * 64 + 4 * c4 + q] = a0[q]; red[kg * 64 + 32 + 4 * c4 + q] = a1[q]; }
        __syncthreads();
        if (tid < 64) { float sm = 0.f;
#pragma unroll 16
            for (int g = 0; g < 64; ++g) sm += red[g * 64 + tid];
            const int bb = tid >> 5, cc = tid & 31; MOD[bb * NMOD + bid * 32 + cc] = sm + p.b_ada[bid * 32 + cc]; }
        __syncthreads();
    }
    {
        float* scr = (float*)(lds + 32768 + wave * 8704);
        constexpr int I1 = 16 * 32, I2 = 16 * 8, I3 = 16 * 16, I4 = 16 * 16, I5 = 16 * 16, I6 = 16 * 8, I7 = 16 * 32, I8 = 16 * 176, I9 = 44 * 32;
        constexpr int NIT = I1 + I2 + I3 + I4 + I5 + I6;
        for (int it = gw; it < NIT; it += NGW) {
            int q = it;
            if (q < I1) { tr_item(p.w_in, INW, 0, WINM, D, 0, scr, q / 32, q % 32, lane); continue; } q -= I1;
            if (q < I2) { tr_item(p.w_in, INW, 1536, WINM, D, 1024, scr, q / 8, q % 8, lane); continue; } q -= I2;
            if (q < I3) { tr_item(p.w_in, INW, 2560, WINM, D, 1280, scr, q / 16, q % 16, lane); continue; } q -= I3;
            if (q < I4) { tr_item(p.w_in, INW, 1024, WINT, D, 0, scr, q / 16, q % 16, lane); continue; } q -= I4;
            if (q < I5) { tr_item(p.w_in, INW, 2048, WINT, D, 512, scr, q / 16, q % 16, lane); continue; } q -= I5;
            tr_item(p.w_in, INW, 1792, WINT, D, 1024, scr, q / 8, q % 8, lane);
        }
        for (int idx = gtid; idx < 16 * 1024; idx += NTH) { const int rr = idx & 15, k = idx >> 4; WGF[(size_t)rr * D + k] = (bf16_t)(cvtpk(p.w_in[(size_t)k * INW + 3072 + rr], 0.f) & 0xffffu); }
    }
    xcd_barrier(xbar);

    norm_mod_rows(p.x, p.g1, MOD + 0 * D, MOD + 1 * D, HB, gw, NGW, lane);
    xcd_barrier(xbar);

    for (int t16 = gw; t16 < M / 16; t16 += NGW) {
        const int fr = lane & 15, fq = lane >> 4;
        const bf16_t* ap = HB + (size_t)(t16 * 16 + fr) * D + 8 * fq;
        const bf16_t* bp = WGF + (size_t)fr * D + 8 * fq;
        f32x4 c4 = {0.f, 0.f, 0.f, 0.f};
#pragma unroll 16
        for (int kk = 0; kk < 32; ++kk) c4 = __builtin_amdgcn_mfma_f32_16x16x32_bf16(*(const bf16x8*)(ap + 32 * kk), *(const bf16x8*)(bp + 32 * kk), c4, 0, 0, 0);
#pragma unroll
        for (int i = 0; i < 4; ++i) GF[(size_t)(t16 * 16 + 4 * fq + i) * 16 + fr] = (bf16_t)(cvtpk(c4[i], 0.f) & 0xffffu);
    }
    {
        pg8::Sched2 S; S.A0 = (const char*)HB; S.B0 = (const char*)WINM; S.A1 = (const char*)WINT; S.B1 = (const char*)HB;
        S.tsA0 = S.tsB0 = S.tsA1 = S.tsB1 = (size_t)256 * D * 2;
        S.nM0 = M / 256; S.nN0 = NA / 256; S.n0 = S.nM0 * S.nN0; S.nM1 = NTR / 256; S.nN1 = M / 256; S.n1 = S.nM1 * S.nN1; S.G = G; S.c = bid;
        pg8::EpiProj E{SQ, SK, SV, GQB, GGB, GKB, GVB};
        pg8::gemm_phase<pg8::EpiProj, pg8::Sched2, true>(ldsl, D, D, S, E);
    }
    xcd_barrier(xbar);

    if (wave < 4) {
        const int gw4 = vcu * 4 + wave, NG4 = G * 4;
        for (int w = gw4; w < 2048; w += NG4) gla_a_unit(GKB, GVB, GF, p.w_fg2, p.b_fg2, KV, DEC, w, lane);
        xcd_barrier_sub4(xbar2, bst + 4, 1u, wave, lane);
        for (int e = bid * 256 + tid; e < 65536; e += G * 256) {
            const int j = e & 63, v = (e >> 6) & 127, h = (e >> 13) & 3, b = e >> 15;
            float st = 0.f;
            for (int n0 = 0; n0 < 128; n0 += 16) {
                float kvv[16], dd[16];
#pragma unroll
                for (int q = 0; q < 16; ++q) { const size_t un = (size_t)(b * 128 + n0 + q) * 4 + h; kvv[q] = KV[un * 8192 + v * 64 + j]; dd[q] = DEC[un * 64 + j]; }
#pragma unroll
                for (int q = 0; q < 16; ++q) { const size_t un = (size_t)(b * 128 + n0 + q) * 4 + h; st = dd[q] * st + kvv[q]; SB[un * 8192 + v * 64 + j] = (bf16_t)(cvtpk(st, 0.f) & 0xffffu); }
            }
        }
        xcd_barrier_sub4(xbar2, bst + 4, 2u, wave, lane);
        for (int w = gw4; w < 2048; w += NG4) gla_c_unit(GQB, GGB, SB, p.g_gla, MIX, w, lane);
    } else {
        const int gw4 = vcu * 4 + (wave - 4), NG4 = G * 4;
        for (int w0 = gw4 * 4; w0 < 4096; w0 += NG4 * 4)
            for (int w = w0; w < w0 + 4; ++w) sb_unit(SQ, SK, SV, MIX, w >> 11, (w >> 8) & 7, w & 255, lane, ldsl + wave * 16384);
        asm volatile("s_waitcnt vmcnt(0)" ::: "memory");
        float* scr = (float*)(lds + wave * 16384);
        constexpr int I7 = 16 * 32, I8 = 16 * 176, I9 = 44 * 32, NCV = I7 + I8 + I9;
#define CV_DESC(q_, d_) do { int q = (q_); \
            if (q < I7) { d_ = TrDesc{p.w_out, D, 0, WOUT, D, 0, q / 32, q % 32}; } \
            else if (q < I7 + I8) { q -= I7; const int kb = q / 176, nb = q % 176, pn = nb >> 3, wi = nb & 7;     \
                d_ = TrDesc{p.w_up, FF2, (wi >> 2) * FF + pn * 128 + (wi & 3) * 32 - 32 * nb, WUP, D, 0, kb, nb}; } \
            else { q -= I7 + I8; d_ = TrDesc{p.w_down, D, 0, WDOWN, FF, 0, q / 32, q % 32}; } } while (0)
        for (int it = bid * 4 + (wave - 4); it < NCV; it += 2 * G * 4) {
            const int it1 = it + G * 4; const bool two = it1 < NCV;
            TrDesc d0, d1; CV_DESC(it, d0); CV_DESC(two ? it1 : it, d1);
            float t0[32], t1[32];
            tr_load(d0, t0, lane);
            if (two) tr_load(d1, t1, lane);
            tr_store(d0, t0, scr, lane);
            if (two) tr_store(d1, t1, scr, lane);
        }
#undef CV_DESC
    }
    xcd_barrier(xbar);

    {
        pg8::Sched2 S; S.A0 = (const char*)MIX; S.B0 = (const char*)WOUT; S.A1 = S.A0; S.B1 = S.B0;
        S.tsA0 = S.tsB0 = S.tsA1 = S.tsB1 = (size_t)256 * D * 2;
        S.nM0 = M / 256; S.nN0 = D / 256; S.n0 = S.nM0 * S.nN0; S.nM1 = 1; S.nN1 = 1; S.n1 = 0; S.G = G; S.c = bid;
        pg8::EpiResNorm<0> E{p.x, p.out, MOD + 2 * D, p.g2, MOD + 4 * D, MOD + 3 * D, HB, (float*)(ws + WS_PART0), (unsigned*)(ws + WS_CNT0), ldsl + 131072 + 1024};
        pg8::gemm_phase<pg8::EpiResNorm<0>, pg8::Sched2, true>(ldsl, D, D, S, E);
    }
    xcd_barrier(xbar);

    {
        pg8::Sched2 S; S.A0 = (const char*)HB; S.B0 = (const char*)WUP; S.A1 = S.A0; S.B1 = S.B0;
        S.tsA0 = S.tsB0 = S.tsA1 = S.tsB1 = (size_t)256 * D * 2;
        S.nM0 = M / 256; S.nN0 = FF2 / 256; S.n0 = S.nM0 * S.nN0; S.nM1 = 1; S.nN1 = 1; S.n1 = 0; S.G = G; S.c = bid;
        pg8::EpiUpConv E{AB, HALO, HEAD, p.w_conv, p.b_conv};
        pg8::gemm_phase<pg8::EpiUpConv, pg8::Sched2, true>(ldsl, D, D, S, E);
    }
    xcd_barrier(xbar);

    for (int idx = gtid; idx < 256 * 352; idx += NTH) {
        const int kb = idx / 352, f0 = (idx % 352) * 8, cv = (f0 >> 7) * 256 + (f0 & 127);
        float wv[3][8], wg[3][8], bv[8], bg[8];
#pragma unroll
        for (int jj = 0; jj < 3; ++jj)
#pragma unroll
            for (int q = 0; q < 8; ++q) { wv[jj][q] = p.w_conv[jj * FF2 + f0 + q]; wg[jj][q] = p.w_conv[jj * FF2 + FF + f0 + q]; }
#pragma unroll
        for (int q = 0; q < 8; ++q) { bv[q] = p.b_conv[f0 + q]; bg[q] = p.b_conv[FF + f0 + q]; }
        float lv[2][8], lg[2][8], hv[2][8], hg[2][8];
#pragma unroll
        for (int rr = 0; rr < 2; ++rr) {
            const bf16_t* hp = HEAD + ((size_t)kb * 2 + rr) * FF2 + cv;
            const u32x4 a = *(const u32x4*)hp, c = *(const u32x4*)(hp + 128);
#pragma unroll
            for (int q = 0; q < 4; ++q) { hv[rr][2 * q] = bflo(a[q]); hv[rr][2 * q + 1] = bfhi(a[q]); hg[rr][2 * q] = bflo(c[q]); hg[rr][2 * q + 1] = bfhi(c[q]); }
            if ((kb & 127) == 0) {
#pragma unroll
                for (int q = 0; q < 8; ++q) { lv[rr][q] = 0.f; lg[rr][q] = 0.f; }
            } else {
                const bf16_t* lp = HALO + ((size_t)(kb - 1) * 2 + rr) * FF2 + cv;
                const u32x4 a2 = *(const u32x4*)lp, c2 = *(const u32x4*)(lp + 128);
#pragma unroll
                for (int q = 0; q < 4; ++q) { lv[rr][2 * q] = bflo(a2[q]); lv[rr][2 * q + 1] = bfhi(a2[q]); lg[rr][2 * q] = bflo(c2[q]); lg[rr][2 * q + 1] = bfhi(c2[q]); }
            }
        }
        float o0[8], o1[8];
#pragma unroll
        for (int q = 0; q < 8; ++q) {
            const float va = bv[q] + wv[0][q] * lv[0][q] + wv[1][q] * lv[1][q] + wv[2][q] * hv[0][q];
            const float ga = bg[q] + wg[0][q] * lg[0][q] + wg[1][q] * lg[1][q] + wg[2][q] * hg[0][q];
            const float vb = bv[q] + wv[0][q] * lv[1][q] + wv[1][q] * hv[0][q] + wv[2][q] * hv[1][q];
            const float gb = bg[q] + wg[0][q] * lg[1][q] + wg[1][q] * hg[0][q] + wg[2][q] * hg[1][q];
            o0[q] = va * (ga * __builtin_amdgcn_rcpf(1.0f + __expf(-ga))); o1[q] = vb * (gb * __builtin_amdgcn_rcpf(1.0f + __expf(-gb)));
        }
        u32x4 s0, s1; s0.x = cvtpk(o0[0], o0[1]); s0.y = cvtpk(o0[2], o0[3]); s0.z = cvtpk(o0[4], o0[5]); s0.w = cvtpk(o0[6], o0[7]);
        s1.x = cvtpk(o1[0], o1[1]); s1.y = cvtpk(o1[2], o1[3]); s1.z = cvtpk(o1[4], o1[5]); s1.w = cvtpk(o1[6], o1[7]);
        *(u32x4*)(AB + (size_t)(kb * 64) * FF + f0) = s0;
        *(u32x4*)(AB + (size_t)(kb * 64 + 1) * FF + f0) = s1;
    }
    xcd_barrier(xbar);

    {
        pg8::Sched2 S; S.A0 = (const char*)AB; S.B0 = (const char*)WDOWN; S.A1 = S.A0; S.B1 = S.B0;
        S.tsA0 = S.tsA1 = (size_t)256 * FF * 2; S.tsB0 = S.tsB1 = (size_t)256 * FF * 2;
        S.nM0 = M / 256; S.nN0 = D / 256; S.n0 = S.nM0 * S.nN0; S.nM1 = 1; S.nN1 = 1; S.n1 = 0; S.G = G; S.c = bid;
        pg8::EpiResNorm<1> E{p.out, p.out, MOD + 5 * D, p.g_final, nullptr, nullptr, nullptr, (float*)(ws + WS_PART1), (unsigned*)(ws + WS_CNT1), ldsl + 131072 + 1024};
        pg8::gemm_phase<pg8::EpiResNorm<1>, pg8::Sched2, true>(ldsl, FF, FF, S, E);
    }

}

extern "C" void kernel_launch(void* const* d_in, const int* in_sizes, int n_in, void* d_out, int out_size, void* d_ws, size_t ws_size, hipStream_t stream) {
    static int grid = 0;
    if (grid == 0) {
        if (n_in != 16 || in_sizes[0] != M * D || out_size != M * D || ws_size < WS_END) { fprintf(stderr, "kernel_launch: unexpected shapes (n_in %d, ws %zu)\n", n_in, ws_size); grid = -1; return; }
        int dev = 0, cus = 0, per_cu = 0;
        hipGetDevice(&dev);
        hipDeviceGetAttribute(&cus, hipDeviceAttributeMultiprocessorCount, dev);
        if (hipFuncSetAttribute((const void*)fwd_megakernel, hipFuncAttributeMaxDynamicSharedMemorySize, LDS_BYTES) != hipSuccess) { fprintf(stderr, "kernel_launch: hipFuncSetAttribute failed\n"); grid = -1; return; }
        if (hipOccupancyMaxActiveBlocksPerMultiprocessor(&per_cu, (const void*)fwd_megakernel, 512, LDS_BYTES) != hipSuccess || per_cu < 1) { fprintf(stderr, "kernel_launch: occupancy query says %d\n", per_cu); per_cu = 1; }
        (void)hipGetLastError();
        grid = cus;
    }
    if (grid < 0) return;
    Params p{};
    p.x = (const float*)d_in[0]; p.c = (const float*)d_in[1]; p.w_ada = (const float*)d_in[2]; p.b_ada = (const float*)d_in[3]; p.g1 = (const float*)d_in[4];
    p.w_in = (const float*)d_in[5]; p.w_fg2 = (const float*)d_in[6]; p.b_fg2 = (const float*)d_in[7]; p.g_gla = (const float*)d_in[8]; p.w_out = (const float*)d_in[9];
    p.g2 = (const float*)d_in[10]; p.w_up = (const float*)d_in[11]; p.w_conv = (const float*)d_in[12]; p.b_conv = (const float*)d_in[13]; p.w_down = (const float*)d_in[14];
    p.g_final = (const float*)d_in[15]; p.out = (float*)d_out; p.ws = (unsigned char*)d_ws;
    if (hipMemsetAsync((char*)d_ws + WS_BAR, 0, WS_CTL_BYTES, stream) != hipSuccess) { fprintf(stderr, "kernel_launch: memset of barrier words failed\n"); return; }
    void* args[] = {&p};
    hipError_t e = hipLaunchCooperativeKernel((const void*)fwd_megakernel, dim3(grid), dim3(512), args, LDS_BYTES, stream);
    if (e != hipSuccess) fprintf(stderr, "cooperative launch failed: %s (grid %d)\n", hipGetErrorString(e), grid);
}
```

```cpp
#include <hip/hip_runtime.h>
#include <hip/hip_cooperative_groups.h>
#include <cstdio>
#include <cstdint>
namespace cg = cooperative_groups;

#define LAS __attribute__((address_space(3)))
typedef unsigned short bf16_t;
typedef short bf16x8 __attribute__((ext_vector_type(8)));
typedef float f32x4 __attribute__((ext_vector_type(4)));
typedef float f32x16 __attribute__((ext_vector_type(16)));
typedef unsigned u32x4 __attribute__((ext_vector_type(4)));
typedef unsigned u32x2 __attribute__((ext_vector_type(2)));
typedef float f32x2_t __attribute__((ext_vector_type(2)));
typedef __bf16 bf16x2_t __attribute__((ext_vector_type(2)));

constexpr int SEQ = 8192, M = 16384, D = 1024, FF = 2816, FF2 = 5632, INW = 3088, NMOD = 6144;
constexpr int NA = 1792;
constexpr int NTR = 1280;
constexpr float EPS = 1e-6f;
constexpr float LOG2E = 1.4426950408889634f;

constexpr size_t MiB = 1u << 20;
constexpr size_t WS_MOD = 0;
constexpr size_t WS_BAR = 64 * 1024;
constexpr size_t WS_CTL_BYTES = 64 * 1024;
constexpr size_t WS_BAR2 = WS_BAR + 49 * 1024;
constexpr size_t WS_CNT0 = WS_BAR + 16 * 1024, WS_CNT1 = WS_BAR + 32 * 1024;
constexpr size_t WS_PART0 = 128 * 1024, WS_PART1 = 384 * 1024;
constexpr size_t WS_WDOWN = 1 * MiB;
constexpr size_t WS_WINM = 13 * MiB;
constexpr size_t WS_WINT = 17 * MiB;
constexpr size_t WS_WOUT = 20 * MiB;
constexpr size_t WS_WUP = 22 * MiB;
constexpr size_t WS_DEC = 33 * MiB;
constexpr size_t WS_GF = 33 * MiB + 512 * 1024;
constexpr size_t WS_WGF = 640 * 1024;
constexpr size_t WS_H = 34 * MiB;
constexpr size_t WS_MIX = 66 * MiB;
constexpr size_t WS_SQ = 98 * MiB;
constexpr size_t WS_SK = 114 * MiB;
constexpr size_t WS_SV = 130 * MiB;
constexpr size_t WS_GQ = 146 * MiB;
constexpr size_t WS_GG = 154 * MiB;
constexpr size_t WS_GK = 170 * MiB;
constexpr size_t WS_GV = 178 * MiB;
constexpr size_t WS_KV = 202 * MiB;
constexpr size_t WS_S = 234 * MiB;
constexpr size_t WS_A = 66 * MiB;
constexpr size_t WS_HALO = 160 * MiB;
constexpr size_t WS_HEAD = 168 * MiB;
constexpr size_t WS_END = 256 * MiB;

constexpr int LDS_BYTES = 147456;

__device__ __forceinline__ unsigned cvtpk(float lo, float hi) { f32x2_t v = {lo, hi}; bf16x2_t b = __builtin_convertvector(v, bf16x2_t); return __builtin_bit_cast(unsigned, b); }
__device__ __forceinline__ float bflo(unsigned w) { return __uint_as_float(w << 16); }
__device__ __forceinline__ float bfhi(unsigned w) { return __uint_as_float(w & 0xffff0000u); }
__device__ __forceinline__ float wave_sum(float v) {
#pragma unroll
    for (int o = 1; o < 64; o <<= 1) v += __shfl_xor(v, o);
    return v;
}
#define MFMA32(a, b, c) __builtin_amdgcn_mfma_f32_32x32x16_bf16((a), (b), (c), 0, 0, 0)
template <int CTRL, bool BC> __device__ __forceinline__ float dppf(float old, float src) {
    return __builtin_bit_cast(float, __builtin_amdgcn_update_dpp(__builtin_bit_cast(int, old), __builtin_bit_cast(int, src), CTRL, 0xf, 0xf, BC));
}

namespace pg8 {
constexpr int BM = 256, BK = 64, HALF = 128, HTB = HALF * BK * 2, STAGE_BYTES = 8 * HTB, NXCD = 8, WGM = 8;
__device__ __forceinline__ int lds_byte(int r, int c) { const int st = (r >> 4) * 2 + (c >> 5), rr = r & 15, cc = c & 31, ob = rr * 64 + cc * 2; return st * 1024 + (ob ^ (((ob >> 9) & 1) << 5)); }
__device__ __forceinline__ void stage_rc(int b, int& R, int& C) { const int st = b / 1024, sb = b % 1024, swz = sb ^ (((sb >> 9) & 1) << 5); R = (st >> 1) * 16 + swz / 64; C = (st & 1) * 32 + (swz % 64) / 2; }
__device__ __forceinline__ int perm32(int rho) { const int n = rho >> 4, i = rho & 15; return 8 * (i >> 2) + 4 * n + (i & 3); }

struct Unit { int pm, pn, kind; };

struct Sched2 {
    const char *A0, *B0, *A1, *B1; size_t tsA0, tsB0, tsA1, tsB1; int nM0, nN0, n0, nM1, nN1, n1, G, c;
    __device__ __forceinline__ static void map(int wgid, int nwg, int nM, int nN, Unit& u) {
        { const int q = nwg / NXCD, r = nwg % NXCD, xcd = wgid % NXCD, off = wgid / NXCD; wgid = (xcd < r ? xcd * (q + 1) : r * (q + 1) + (xcd - r) * q) + off; }
        const int nig = WGM * nN, gid = wgid / nig, fm = gid * WGM, gsz = (nM - fm) < WGM ? (nM - fm) : WGM;
        u.pm = fm + ((wgid % nig) % gsz); u.pn = (wgid % nig) / gsz;
    }
    __device__ __forceinline__ bool next(int i, Unit& u) const {
        const long L = (long)i * G + c; if (L >= n0 + n1) return false;
        if (L < n0) { map((int)L, n0, nM0, nN0, u); u.kind = 0; } else { map((int)L - n0, n1, nM1, nN1, u); u.kind = 1; }
        return true;
    }
    __device__ __forceinline__ const char* baseA(const Unit& u) const { return u.kind ? A1 + (size_t)u.pm * tsA1 : A0 + (size_t)u.pm * tsA0; }
    __device__ __forceinline__ const char* baseB(const Unit& u) const { return u.kind ? B1 + (size_t)u.pn * tsB1 : B0 + (size_t)u.pn * tsB0; }
};

template <class Epi, class Sched, bool ALIGN_EPI>
__device__ __forceinline__ void gemm_phase(LAS unsigned char* lds, const int K, const int lda, const Sched& S, const Epi& E) {
    int tid_ = threadIdx.x; asm volatile("" : "+v"(tid_));
    const int tid = tid_, wid = __builtin_amdgcn_readfirstlane(tid >> 6), lane = tid & 63, wr = wid >> 2, wc = wid & 3, fr = lane & 15, fq = lane >> 4;
    const int nt = K / BK;
    unsigned voffA[2], voffB[2];
#pragma unroll
    for (int i = 0; i < 2; ++i) { int R, C; stage_rc(tid * 16 + i * 8192, R, C); const int Rb = Epi::PERM ? ((R & ~31) + perm32(R & 31)) : R;
        const int Ra = Epi::APERM ? ((R & 64) + 4 * (R & 15) + ((R & 63) >> 4)) : R;
        voffA[i] = (unsigned)(Ra * lda + C) * 2u; voffB[i] = (unsigned)(Rb * K + C) * 2u; }
    const size_t kstep = (size_t)(BK * 2);
    const size_t hsA = (size_t)HALF * lda * 2, hsB = (size_t)HALF * K * 2;
    const unsigned ldsw = (unsigned)wid * 1024u;
    const int aoff = lds_byte(wr * 64 + fr, fq * 8), boff = lds_byte(wc * 32 + fr, fq * 8);
#define PG8_SA(b, h) (((b) * 2 + (h)) * HTB)
#define PG8_SB(b, h) ((4 + (b) * 2 + (h)) * HTB)
#define PG8_STAGE(bufoff, gbase, voff) do { _Pragma("unroll") for (int _i = 0; _i < 2; ++_i) \
        __builtin_amdgcn_global_load_lds((const unsigned*)((const char*)(gbase) + (voff)[_i]), (LAS unsigned*)(lds + (bufoff) + ldsw + _i * 8192), 16, 0, 0); } while (0)
#define PG8_LDA(dst, b, h) do { _Pragma("unroll") for (int m = 0; m < 4; ++m) _Pragma("unroll") for (int k = 0; k < 2; ++k) dst[m][k] = *(const LAS bf16x8*)(lds + PG8_SA(b, h) + aoff + m * 2048 + k * 1024); } while (0)
#define PG8_LDB(dst, b, h) do { _Pragma("unroll") for (int n = 0; n < 2; ++n) _Pragma("unroll") for (int k = 0; k < 2; ++k) dst[n][k] = *(const LAS bf16x8*)(lds + PG8_SB(b, h) + boff + n * 2048 + k * 1024); } while (0)
#define PG8_MMA(ai, bj, At, Bt) do { __builtin_amdgcn_s_setprio(1); _Pragma("unroll") for (int m = 0; m < 4; ++m) _Pragma("unroll") for (int n = 0; n < 2; ++n) _Pragma("unroll") for (int k = 0; k < 2; ++k) \
        acc[ai][bj][m][n] = __builtin_amdgcn_mfma_f32_16x16x32_bf16(Bt[n][k], At[m][k], acc[ai][bj][m][n], 0, 0, 0); __builtin_amdgcn_s_setprio(0); } while (0)
#define PG8_WAIT_V(n) asm volatile("s_waitcnt vmcnt(" #n ")" ::: "memory")
#define PG8_WAIT_L(n) asm volatile("s_waitcnt lgkmcnt(" #n ")" ::: "memory")
#define PG8_BAR __builtin_amdgcn_s_barrier()
#define PG8_SCHED __builtin_amdgcn_sched_barrier(0)
    Unit cur, nxt; int ui = 0;
    if (!S.next(0, cur)) return;
    f32x4 acc[2][2][4][2];
#pragma unroll
    for (int a = 0; a < 2; ++a)
#pragma unroll
        for (int b = 0; b < 2; ++b)
#pragma unroll
            for (int m = 0; m < 4; ++m)
#pragma unroll
                for (int n = 0; n < 2; ++n) acc[a][b][m][n] = (f32x4){0.f, 0.f, 0.f, 0.f};
    bf16x8 At[4][2], B0[2][2], B1[2][2];
    const char* cA = S.baseA(cur); const char* cB = S.baseB(cur);
    PG8_STAGE(PG8_SB(0, 0), cB, voffB); PG8_STAGE(PG8_SB(0, 1), cB + hsB, voffB); PG8_STAGE(PG8_SA(0, 0), cA, voffA); PG8_STAGE(PG8_SA(0, 1), cA + hsA, voffA);
    if (wr == 1) PG8_BAR;
    PG8_WAIT_V(2); PG8_BAR;
    PG8_STAGE(PG8_SB(1, 0), cB + kstep, voffB); PG8_STAGE(PG8_SA(1, 0), cA + kstep, voffA); PG8_STAGE(PG8_SB(1, 1), cB + hsB + kstep, voffB);
    PG8_WAIT_V(6); PG8_BAR;
    for (;;) {
        const bool has_next = S.next(ui + 1, nxt);
        const char* nA = has_next ? S.baseA(nxt) : cA; const char* nB = has_next ? S.baseB(nxt) : cB;
        for (int t = 0; t < nt; t += 2) {
            const bool last = (t == nt - 2);
            const char* a1 = cA + (size_t)(t + 1) * kstep;
            const char* a2 = last ? nA : cA + (size_t)(t + 2) * kstep; const char* b2 = last ? nB : cB + (size_t)(t + 2) * kstep;
            const char* a3 = a2 + kstep; const char* b3 = b2 + kstep;
            PG8_LDB(B0, 0, 0); PG8_LDB(B1, 0, 1); PG8_SCHED; PG8_LDA(At, 0, 0); PG8_STAGE(PG8_SA(1, 1), a1 + hsA, voffA);
            PG8_WAIT_V(8); PG8_WAIT_L(0); PG8_BAR; PG8_MMA(0, 0, At, B0); PG8_MMA(0, 1, At, B1); PG8_BAR; PG8_SCHED;
            PG8_LDA(At, 0, 1); PG8_STAGE(PG8_SB(0, 0), b2, voffB); PG8_STAGE(PG8_SB(0, 1), b2 + hsB, voffB); PG8_STAGE(PG8_SA(0, 0), a2, voffA);
            PG8_WAIT_V(8); PG8_WAIT_L(0); PG8_BAR; PG8_MMA(1, 0, At, B0); PG8_MMA(1, 1, At, B1); PG8_BAR; PG8_SCHED;
            PG8_LDB(B0, 1, 0); PG8_LDB(B1, 1, 1); PG8_SCHED; PG8_LDA(At, 1, 0); PG8_STAGE(PG8_SA(0, 1), a2 + hsA, voffA);
            PG8_WAIT_V(8); PG8_WAIT_L(0); PG8_BAR; PG8_MMA(0, 0, At, B0); PG8_MMA(0, 1, At, B1); PG8_BAR; PG8_SCHED;
            PG8_LDA(At, 1, 1); PG8_STAGE(PG8_SB(1, 0), b3, voffB); PG8_STAGE(PG8_SB(1, 1), b3 + hsB, voffB); PG8_STAGE(PG8_SA(1, 0), a3, voffA);
            PG8_WAIT_V(8); PG8_WAIT_L(0); PG8_BAR; PG8_MMA(1, 0, At, B0); PG8_MMA(1, 1, At, B1); PG8_BAR; PG8_SCHED;
        }
        if constexpr (ALIGN_EPI) { if (wr == 0) PG8_BAR; }
        E(acc, cur, wr, wc, fr, fq);
        if (!has_next) break;
#pragma unroll
        for (int a = 0; a < 2; ++a)
#pragma unroll
            for (int b = 0; b < 2; ++b)
#pragma unroll
                for (int m = 0; m < 4; ++m)
#pragma unroll
                    for (int n = 0; n < 2; ++n) acc[a][b][m][n] = (f32x4){0.f, 0.f, 0.f, 0.f};
        cur = nxt; cA = nA; cB = nB; ++ui;
        if constexpr (ALIGN_EPI) { if (wr == 1) PG8_BAR; }
    }
    PG8_WAIT_V(0);
    if constexpr (!ALIGN_EPI) { if (wr == 0) PG8_BAR; }
    PG8_BAR;
#undef PG8_SA
#undef PG8_SB
#undef PG8_STAGE
#undef PG8_LDA
#undef PG8_LDB
#undef PG8_MMA
#undef PG8_WAIT_V
#undef PG8_WAIT_L
#undef PG8_BAR
#undef PG8_SCHED
}

struct EpiProj {
    static constexpr bool PERM = true, APERM = false;
    bf16_t *SQ, *SK, *SV, *GQ, *GG, *GK, *GV;
    __device__ __forceinline__ void operator()(const f32x4 (&acc)[2][2][4][2], const Unit& u, int wr, int wc, int fr, int fq) const {
        const int row0 = u.pm * BM + wr * 64 + fr, col0 = u.pn * BM + wc * 32 + 8 * fq;
#pragma unroll
        for (int ai = 0; ai < 2; ++ai)
#pragma unroll
            for (int m = 0; m < 4; ++m) {
                const int row = row0 + ai * HALF + m * 16;
#pragma unroll
                for (int bj = 0; bj < 2; ++bj) {
                    const int col = col0 + bj * HALF;
                    f32x4 v0 = acc[ai][bj][m][0], v1 = acc[ai][bj][m][1];
                    if (u.kind == 0 && u.pn < 2) { v0 = v0 * (0.125f * LOG2E); v1 = v1 * (0.125f * LOG2E); }
                    u32x4 w; w.x = cvtpk(v0[0], v0[1]); w.y = cvtpk(v0[2], v0[3]); w.z = cvtpk(v1[0], v1[1]); w.w = cvtpk(v1[2], v1[3]);
                    bf16_t* dst;
                    if (u.kind == 0) {
                        const int b = row >> 13, t = row & 8191;
                        if (u.pn < 2)       dst = SQ + ((size_t)((b * 8 + (col >> 6)) * SEQ + t) * 64 + (col & 63));
                        else if (u.pn < 4)  { const int c2 = col - 512;  dst = SK + ((size_t)((b * 8 + (c2 >> 6)) * SEQ + t) * 64 + (c2 & 63)); }
                        else if (u.pn < 5)  { const int c2 = col - 1024; dst = GQ + ((size_t)((b * 4 + (c2 >> 6)) * SEQ + t) * 64 + (c2 & 63)); }
                        else                { const int c2 = col - 1280; dst = GG + ((size_t)((b * 4 + (c2 >> 7)) * SEQ + t) * 128 + (c2 & 127)); }
                    } else {
                        const int b = col >> 13, t = col & 8191;
                        if (u.pm < 2)       dst = SV + ((size_t)(((b * 8 + (row >> 6)) * 256 + (t >> 5)) * 64 + (row & 63)) * 32 + (t & 31));
                        else if (u.pm < 4)  { const int f2 = row - 512;  dst = GV + ((size_t)(((b * 4 + (f2 >> 7)) * 128 + (t >> 6)) * 128 + (f2 & 127)) * 64 + (t & 63)); }
                        else                { const int f2 = row - 1024; dst = GK + ((size_t)(((b * 4 + (f2 >> 6)) * 128 + (t >> 6)) * 64 + (f2 & 63)) * 64 + (t & 63)); }
                    }
                    *(u32x4*)dst = w;
                }
            }
    }
};
struct EpiUpConv {
    static constexpr bool PERM = true, APERM = true;
    bf16_t* A; bf16_t* halo; bf16_t* head; const float* w_conv; const float* b_conv;
    __device__ __forceinline__ void operator()(f32x4 (&acc)[2][2][4][2], const Unit& u, int wr, int wc, int fr, int fq) const {
        const int row0 = u.pm * BM + wr * 64 + 4 * fr;
        const int cl = wc * 32 + 8 * fq;
        const int f0 = u.pn * HALF + cl;
        if (fr == 15 || fr == 0) {
#pragma unroll
            for (int ai = 0; ai < 2; ++ai)
#pragma unroll
                for (int bj = 0; bj < 2; ++bj)
#pragma unroll
                    for (int q = 0; q < 2; ++q) {
                        const int m = (fr == 15) ? 2 + q : q;
                        const f32x4 v0 = (fr == 15) ? acc[ai][bj][2 + q][0] : acc[ai][bj][q][0], v1 = (fr == 15) ? acc[ai][bj][2 + q][1] : acc[ai][bj][q][1];
                        u32x4 w; w.x = cvtpk(v0[0], v0[1]); w.y = cvtpk(v0[2], v0[3]); w.z = cvtpk(v1[0], v1[1]); w.w = cvtpk(v1[2], v1[3]);
                        bf16_t* side = (fr == 15) ? halo : head;
                        *(u32x4*)(side + ((size_t)((row0 + ai * HALF + m) >> 6) * 2 + q) * FF2 + u.pn * BM + bj * HALF + cl) = w;
                    }
        }
#pragma unroll
        for (int n = 0; n < 2; ++n)
#pragma unroll
            for (int bj = 0; bj < 2; ++bj) {
                const int fc = bj * FF + f0 + 4 * n;
                const f32x4 w0 = *(const f32x4*)(w_conv + fc), w1 = *(const f32x4*)(w_conv + FF2 + fc), w2 = *(const f32x4*)(w_conv + 2 * FF2 + fc), bb = *(const f32x4*)(b_conv + fc);
#pragma unroll
                for (int ai = 0; ai < 2; ++ai) {
                    const f32x4 r0 = acc[ai][bj][0][n], r1 = acc[ai][bj][1][n], r2 = acc[ai][bj][2][n], r3 = acc[ai][bj][3][n];
                    f32x4 s3, s2;
#pragma unroll
                    for (int j = 0; j < 4; ++j) { s3[j] = dppf<0x111, true>(0.f, r3[j]); s2[j] = dppf<0x111, true>(0.f, r2[j]); }
                    acc[ai][bj][3][n] = bb + w0 * r1 + w1 * r2 + w2 * r3;
                    acc[ai][bj][2][n] = bb + w0 * r0 + w1 * r1 + w2 * r2;
                    acc[ai][bj][1][n] = bb + w0 * s3 + w1 * r0 + w2 * r1;
                    acc[ai][bj][0][n] = bb + w0 * s2 + w1 * s3 + w2 * r0;
                }
            }
#pragma unroll
        for (int ai = 0; ai < 2; ++ai)
#pragma unroll
            for (int m = 0; m < 4; ++m) {
                const int row = row0 + ai * HALF + m;
                float o[8];
#pragma unroll
                for (int n = 0; n < 2; ++n)
#pragma unroll
                    for (int j = 0; j < 4; ++j) { const float v = acc[ai][0][m][n][j], g = acc[ai][1][m][n][j]; o[4 * n + j] = v * (g * __builtin_amdgcn_rcpf(1.0f + __expf(-g))); }
                u32x4 w; w.x = cvtpk(o[0], o[1]); w.y = cvtpk(o[2], o[3]); w.z = cvtpk(o[4], o[5]); w.w = cvtpk(o[6], o[7]);
                *(u32x4*)(A + (size_t)row * FF + f0) = w;
            }
    }
};

template <int MODE> struct EpiResNorm {
    static constexpr bool PERM = false, APERM = false;
    const float* base; float* out; const float* gate; const float* gain; const float* scale; const float* shift; bf16_t* hb; float* part; unsigned* cnt; LAS unsigned char* xl;
    __device__ __forceinline__ void operator()(f32x4 (&acc)[2][2][4][2], const Unit& u, int wr, int wc, int fr, int fq) const {
        int tid = threadIdx.x; asm volatile("" : "+v"(tid));
        LAS float* P = (LAS float*)xl;
        LAS float* S = (LAS float*)(xl + 4096);
        const int rl0 = wr * 64 + fr, col0 = u.pn * BM + wc * 32 + 4 * fq, bb = u.pm >> 5;
        const int rbase = (u.pm * BM + rl0) * D + col0;
        const float* gp = gate + (size_t)bb * NMOD;
        f32x4 rb0[8], rb1[8];
#define RN_LOAD(g, dst) do { _Pragma("unroll") for (int ai = 0; ai < 2; ++ai) _Pragma("unroll") for (int m = 0; m < 4; ++m) { \
            int off = rbase; asm volatile("" : "+v"(off)); off += (ai * HALF + m * 16) * D + ((g) >> 1) * HALF + ((g) & 1) * 16; \
            dst[ai * 4 + m] = __builtin_nontemporal_load((const f32x4*)(base + off)); } } while (0)
#define RN_USE(g, src) do { const f32x4 gv = *(const f32x4*)(gp + col0 + ((g) >> 1) * HALF + ((g) & 1) * 16) + 1.0f; \
            _Pragma("unroll") for (int ai = 0; ai < 2; ++ai) _Pragma("unroll") for (int m = 0; m < 4; ++m) acc[ai][(g) >> 1][m][(g) & 1] = src[ai * 4 + m] + gv * acc[ai][(g) >> 1][m][(g) & 1]; \
            asm volatile("" : "+v"(acc[0][(g) >> 1][0][(g) & 1]), "+v"(acc[0][(g) >> 1][1][(g) & 1]), "+v"(acc[0][(g) >> 1][2][(g) & 1]), "+v"(acc[0][(g) >> 1][3][(g) & 1]), \
                               "+v"(acc[1][(g) >> 1][0][(g) & 1]), "+v"(acc[1][(g) >> 1][1][(g) & 1]), "+v"(acc[1][(g) >> 1][2][(g) & 1]), "+v"(acc[1][(g) >> 1][3][(g) & 1]) :: "memory"); } while (0)
        RN_LOAD(0, rb0); RN_LOAD(1, rb1);
        RN_USE(0, rb0);  RN_LOAD(2, rb0);
        RN_USE(1, rb1);  RN_LOAD(3, rb1);
        RN_USE(2, rb0);  RN_USE(3, rb1);
#undef RN_LOAD
#undef RN_USE
#pragma unroll
        for (int ai = 0; ai < 2; ++ai)
#pragma unroll
            for (int m = 0; m < 4; ++m) {
                float sq = 0.f;
#pragma unroll
                for (int bj = 0; bj < 2; ++bj)
#pragma unroll
                    for (int n = 0; n < 2; ++n) { const f32x4 v = acc[ai][bj][m][n]; sq += (v.x * v.x + v.y * v.y) + (v.z * v.z + v.w * v.w); }
                sq += __shfl_xor(sq, 16); sq += __shfl_xor(sq, 32);
                if (fq == 0) P[(ai * HALF + rl0 + m * 16) * 4 + wc] = sq;
            }
        asm volatile("s_waitcnt lgkmcnt(0)" ::: "memory"); __builtin_amdgcn_s_barrier(); asm volatile("" ::: "memory");
        if (tid < 256) {
            const float tot = (P[tid * 4 + 0] + P[tid * 4 + 1]) + (P[tid * 4 + 2] + P[tid * 4 + 3]);
            __hip_atomic_store(part + ((size_t)(u.pm * 4 + u.pn) * 256 + tid), tot, __ATOMIC_RELAXED, __HIP_MEMORY_SCOPE_AGENT);
        }
        asm volatile("s_waitcnt vmcnt(0) lgkmcnt(0)" ::: "memory"); __builtin_amdgcn_s_barrier(); asm volatile("" ::: "memory");
        if (tid == 0) {
            unsigned* cw = cnt + 64 * u.pm;
            __hip_atomic_fetch_add(cw, 1u, __ATOMIC_RELAXED, __HIP_MEMORY_SCOPE_AGENT);
            unsigned sp = 0u;
            while (__hip_atomic_load(cw, __ATOMIC_RELAXED, __HIP_MEMORY_SCOPE_AGENT) < 4u) { __builtin_amdgcn_s_sleep(1); if (++sp > (1u << 22)) break; }
            __builtin_amdgcn_fence(__ATOMIC_ACQUIRE, "agent");
        }
        asm volatile("s_waitcnt vmcnt(0) lgkmcnt(0)" ::: "memory"); __builtin_amdgcn_s_barrier(); asm volatile("" ::: "memory");
        if (tid < 256) {
            float t = 0.f;
#pragma unroll
            for (int j = 0; j < 4; ++j) t += __hip_atomic_load(part + ((size_t)(u.pm * 4 + j) * 256 + tid), __ATOMIC_RELAXED, __HIP_MEMORY_SCOPE_AGENT);
            S[tid] = 1.0f / sqrtf(t * (1.0f / D) + EPS);
        }
        asm volatile("s_waitcnt vmcnt(0) lgkmcnt(0)" ::: "memory"); __builtin_amdgcn_s_barrier(); asm volatile("" ::: "memory");
#pragma unroll
        for (int bj = 0; bj < 2; ++bj)
#pragma unroll
            for (int n = 0; n < 2; ++n) {
                const int c = col0 + bj * HALF + n * 16;
                const f32x4 gn = *(const f32x4*)(gain + c);
                f32x4 sc1 = {0.f, 0.f, 0.f, 0.f}, sh = {0.f, 0.f, 0.f, 0.f};
                if (MODE == 0) { sc1 = *(const f32x4*)(scale + (size_t)bb * NMOD + c) + 1.0f; sh = *(const f32x4*)(shift + (size_t)bb * NMOD + c); }
#pragma unroll
                for (int ai = 0; ai < 2; ++ai)
#pragma unroll
                    for (int m = 0; m < 4; ++m) {
                        const int rl = ai * HALF + rl0 + m * 16;
                        int off = rbase; asm volatile("" : "+v"(off));
                        off += (ai * HALF + m * 16) * D + bj * HALF + n * 16;
                        const float r = S[rl];
                        const f32x4 v = acc[ai][bj][m][n];
                        if (MODE == 0) {
                            __builtin_nontemporal_store(v, (f32x4*)(out + off));
                            const f32x4 h = (v * r * gn) * sc1 + sh;
                            u32x2 w; w.x = cvtpk(h.x, h.y); w.y = cvtpk(h.z, h.w);
                            *(u32x2*)(hb + off) = w;
                        } else {
                            __builtin_nontemporal_store(v * r * gn, (f32x4*)(out + off));
                        }
                        asm volatile("" ::: "memory");
                    }
            }
    }
};
}

#define XB_TMO      128
#define XB_XCNT(j)  (256  + 64 * (j))
#define XB_XSUB(j)  (1280 + 64 * (j))
#define XB_XGEN(j)  (2304 + 64 * (j))
#define XB_TOP      3328
#define XB_TOPGEN   3392
#define XCD_BAR_WORDS 3456
#define XB_SPIN_CAP (1u << 18)
__device__ __forceinline__ unsigned xb_ld(unsigned* p)              { return __hip_atomic_load(p, __ATOMIC_RELAXED, __HIP_MEMORY_SCOPE_AGENT); }
__device__ __forceinline__ unsigned xb_add(unsigned* p, unsigned v) { return __hip_atomic_fetch_add(p, v, __ATOMIC_RELAXED, __HIP_MEMORY_SCOPE_AGENT); }
__device__ __forceinline__ unsigned xb_xcc_id() { return (unsigned)__builtin_amdgcn_s_getreg((3 << 11) | 20) & 0xFu; }
#define XB_SPIN(cond, bar) do { unsigned _sp = 0; while (cond) { __builtin_amdgcn_s_sleep(1); \
    if ((++_sp & 255u) == 0u) { if (xb_ld(&(bar)[XB_TMO])) break; if (_sp > XB_SPIN_CAP) { atomicAdd(&(bar)[XB_TMO], 1u); break; } } } } while (0)
struct XcdBarrier { unsigned* bar; unsigned x; volatile LAS unsigned* st; };
__device__ __forceinline__ XcdBarrier xcd_barrier_post(unsigned* bar, volatile LAS unsigned* st) {
    XcdBarrier b; b.bar = bar; b.x = xb_xcc_id(); b.st = st;
    if (threadIdx.x == 0) (void)xb_add(&bar[XB_XCNT(b.x)], 1u);
    return b;
}
__device__ __forceinline__ void xcd_barrier_complete(unsigned* bar, unsigned x, unsigned& nloc, unsigned& nx) {
    const unsigned G = gridDim.x * gridDim.y * gridDim.z;
    unsigned sum, cnt, mine, sp = 0u;
    for (;;) {
        sum = 0u; cnt = 0u; mine = 0u;
#pragma unroll
        for (unsigned j = 0; j < 16; ++j) { const unsigned c = xb_ld(&bar[XB_XCNT(j)]); sum += c; cnt += (c > 0u) ? 1u : 0u; mine = (j == x) ? c : mine; }
        if (sum == G) break;
        __builtin_amdgcn_s_sleep(1);
        if ((++sp & 255u) == 0u) { if (xb_ld(&bar[XB_TMO])) break; if (sp > XB_SPIN_CAP) { atomicAdd(&bar[XB_TMO], 1u); break; } }
    }
    nloc = mine > 0u ? mine : 1u; nx = cnt > 0u ? cnt : 1u;
}
__device__ __forceinline__ void xcd_barrier(const XcdBarrier& b) {
    asm volatile("s_waitcnt vmcnt(0)" ::: "memory");
    __syncthreads();
    if (threadIdx.x == 0) {
        unsigned* bar = b.bar;
        __builtin_amdgcn_s_waitcnt(0);
        unsigned nloc = b.st[0], nx = b.st[1];
        if (nloc == 0u) { xcd_barrier_complete(bar, b.x, nloc, nx); b.st[0] = nloc; b.st[1] = nx; }
        const unsigned old = xb_add(&bar[XB_XSUB(b.x)], 1u);
        const unsigned gen = old / nloc;
        if (old + 1u == (gen + 1u) * nloc) {
            __builtin_amdgcn_fence(__ATOMIC_RELEASE, "agent");
            asm volatile("s_waitcnt vmcnt(0)" ::: "memory");
            const unsigned og = xb_add(&bar[XB_TOP], 1u);
            const unsigned tg = og / nx;
            if (og + 1u == (tg + 1u) * nx) xb_add(&bar[XB_TOPGEN], 1u);
            else XB_SPIN(xb_ld(&bar[XB_TOPGEN]) == tg, bar);
            __builtin_amdgcn_fence(__ATOMIC_ACQUIRE, "agent");
            xb_add(&bar[XB_XGEN(b.x)], 1u);
            asm volatile("s_waitcnt vmcnt(0)" ::: "memory");
        } else {
            XB_SPIN(xb_ld(&bar[XB_XGEN(b.x)]) == gen, bar);
            __builtin_amdgcn_fence(__ATOMIC_ACQUIRE, "agent");
            asm volatile("s_waitcnt vmcnt(0)" ::: "memory");
        }
    }
    __syncthreads();
}

__device__ __forceinline__ void xcd_barrier_sub4(const XcdBarrier& b, volatile LAS unsigned* lw, unsigned round, int wave, int lane) {
    asm volatile("s_waitcnt vmcnt(0) lgkmcnt(0)" ::: "memory");
    if (lane == 0) {
        __hip_atomic_fetch_add((LAS unsigned*)&lw[0], 1u, __ATOMIC_RELAXED, __HIP_MEMORY_SCOPE_WORKGROUP);
        if (wave == 0) {
            { unsigned sp = 0u; while (lw[0] < 4u * round) { __builtin_amdgcn_s_sleep(1); if (++sp > (1u << 24)) break; } }
            unsigned* bar = b.bar;
            __builtin_amdgcn_s_waitcnt(0);
            unsigned nloc = b.st[0], nx = b.st[1];
            if (nloc == 0u) { xcd_barrier_complete(bar, b.x, nloc, nx); b.st[0] = nloc; b.st[1] = nx; }
            const unsigned old = xb_add(&bar[XB_XSUB(b.x)], 1u);
            const unsigned gen = old / nloc;
            if (old + 1u == (gen + 1u) * nloc) {
                __builtin_amdgcn_fence(__ATOMIC_RELEASE, "agent");
                asm volatile("s_waitcnt vmcnt(0)" ::: "memory");
                const unsigned og = xb_add(&bar[XB_TOP], 1u);
                const unsigned tg = og / nx;
                if (og + 1u == (tg + 1u) * nx) xb_add(&bar[XB_TOPGEN], 1u);
                else XB_SPIN(xb_ld(&bar[XB_TOPGEN]) == tg, bar);
                __builtin_amdgcn_fence(__ATOMIC_ACQUIRE, "agent");
                xb_add(&bar[XB_XGEN(b.x)], 1u);
                asm volatile("s_waitcnt vmcnt(0)" ::: "memory");
            } else {
                XB_SPIN(xb_ld(&bar[XB_XGEN(b.x)]) == gen, bar);
                __builtin_amdgcn_fence(__ATOMIC_ACQUIRE, "agent");
                asm volatile("s_waitcnt vmcnt(0)" ::: "memory");
            }
            lw[1] = round;
            asm volatile("s_waitcnt lgkmcnt(0)" ::: "memory");
        } else {
            unsigned sp = 0u; while (lw[1] < round) { __builtin_amdgcn_s_sleep(2); if (++sp > (1u << 24)) break; }
        }
    }
    asm volatile("" ::: "memory");
}

struct Params {
    const float *x, *c, *w_ada, *b_ada, *g1, *w_in, *w_fg2, *b_fg2, *g_gla, *w_out, *g2, *w_up, *w_conv, *b_conv, *w_down, *g_final;
    float* out; unsigned char* ws;
};

struct TrDesc { const float* W; int ld, c0; bf16_t* WT; int Kd, r0, kb, nb; };
__device__ __forceinline__ void tr_load(const TrDesc& d, float (&tv)[32], int lane) {
    const int k0 = 64 * d.kb, n0 = 32 * d.nb;
#pragma unroll
    for (int i = 0; i < 32; ++i) tv[i] = __builtin_nontemporal_load(d.W + (size_t)(k0 + 2 * i + (lane >> 5)) * d.ld + d.c0 + n0 + (lane & 31));
}
__device__ __forceinline__ void tr_store(const TrDesc& d, const float (&tv)[32], float* scr, int lane) {
    const int k0 = 64 * d.kb, n0 = 32 * d.nb;
#pragma unroll
    for (int i = 0; i < 32; ++i) scr[(2 * i + (lane >> 5)) * 33 + (lane & 31)] = tv[i];
    asm volatile("s_waitcnt lgkmcnt(0)" ::: "memory");
    const int c = lane & 7;
#pragma unroll
    for (int j = 0; j < 4; ++j) { const int n = (lane >> 3) + 8 * j; const float* sp = scr + (8 * c) * 33 + n;
        u32x4 o; o.x = cvtpk(sp[0 * 33], sp[1 * 33]); o.y = cvtpk(sp[2 * 33], sp[3 * 33]); o.z = cvtpk(sp[4 * 33], sp[5 * 33]); o.w = cvtpk(sp[6 * 33], sp[7 * 33]);
        *(u32x4*)(d.WT + (size_t)(d.r0 + n0 + n) * d.Kd + k0 + 8 * c) = o; }
    asm volatile("s_waitcnt lgkmcnt(0)" ::: "memory");
}
__device__ __forceinline__ void tr_item(const float* W, int ld, int c0, bf16_t* WT, int Kd, int r0, float* scr, int kb, int nb, int lane) {
    const TrDesc d{W, ld, c0, WT, Kd, r0, kb, nb};
    float tv[32];
    tr_load(d, tv, lane);
    tr_store(d, tv, scr, lane);
}

__device__ __forceinline__ void norm_mod_rows(const float* X, const float* gain, const float* shift, const float* scale, bf16_t* H, int gw, int NGW, int lane) {
    for (int m0 = gw; m0 < M; m0 += 4 * NGW) {
        f32x4 v[4][4];
#pragma unroll
        for (int q = 0; q < 4; ++q) {
            const int m = m0 + q * NGW;
            const f32x4* xr = (const f32x4*)(X + (size_t)(m < M ? m : m0) * D) + lane;
#pragma unroll
            for (int j = 0; j < 4; ++j) v[q][j] = __builtin_nontemporal_load(xr + 64 * j);
        }
#pragma unroll
        for (int q = 0; q < 4; ++q) {
            const int m = m0 + q * NGW;
            if (m >= M) break;
            const int b = m >> 13;
            float ss = 0.f;
#pragma unroll
            for (int j = 0; j < 4; ++j) ss += (v[q][j].x * v[q][j].x + v[q][j].y * v[q][j].y) + (v[q][j].z * v[q][j].z + v[q][j].w * v[q][j].w);
            const float r = 1.0f / sqrtf(wave_sum(ss) * (1.0f / D) + EPS);
            unsigned long long* o8 = (unsigned long long*)(H + (size_t)m * D) + lane;
#pragma unroll
            for (int j = 0; j < 4; ++j) {
                const f32x4 g = ((const f32x4*)gain)[64 * j + lane], sc = ((const f32x4*)(scale + (size_t)b * NMOD))[64 * j + lane], sh = ((const f32x4*)(shift + (size_t)b * NMOD))[64 * j + lane];
                const f32x4 o = (v[q][j] * r * g) * (sc + 1.0f) + sh;
                o8[64 * j] = (unsigned long long)cvtpk(o.x, o.y) | ((unsigned long long)cvtpk(o.z, o.w) << 32);
            }
        }
    }
}

__device__ __forceinline__ int crow(int r, int hi) { return (r & 3) + 8 * (r >> 2) + 4 * hi; }

__device__ __forceinline__ void sb_unit(const bf16_t* SQ, const bf16_t* SK, const bf16_t* SV, bf16_t* MIX, int b, int h, int qi, int lane, LAS unsigned char* lbuf) {
    const int r = lane & 31, hh = lane >> 5;
    const int pr = (r & 0x13) | ((r & 4) << 1) | ((r & 8) >> 1);
    const size_t tq = (size_t)b * SEQ + (size_t)qi * 32;
    bf16x8 qf[4];
#pragma unroll
    for (int d0 = 0; d0 < 4; ++d0) qf[d0] = *(const bf16x8*)(SQ + ((size_t)(b * 8 + h) * SEQ + (size_t)qi * 32 + r) * 64 + 16 * d0 + 8 * hh);
    f32x16 o0, o1;
#pragma unroll
    for (int i = 0; i < 16; ++i) { o0[i] = 0.f; o1[i] = 0.f; }
    float R = 0.f;
    const bf16_t* kbase = SK + ((size_t)(b * 8 + h) * SEQ + pr) * 64 + 8 * hh;
    const bf16_t* vbase = SV + ((size_t)(b * 8 + h) * 256 * 64 + r) * 32 + 8 * hh;
    LAS unsigned char* wbuf = lbuf + 16 * lane;
    int cur = 0;
#define SB_DMA(kt_, bufsel) do { const int k0_ = (kt_) * 32; LAS unsigned char* d_ = lbuf + (bufsel) * 8192; \
        _Pragma("unroll") for (int d0 = 0; d0 < 4; ++d0) __builtin_amdgcn_global_load_lds((const unsigned*)(kbase + (size_t)k0_ * 64 + 16 * d0), (LAS unsigned*)(d_ + d0 * 1024), 16, 0, 0); \
        _Pragma("unroll") for (int db = 0; db < 2; ++db) _Pragma("unroll") for (int s = 0; s < 2; ++s) \
            __builtin_amdgcn_global_load_lds((const unsigned*)(vbase + (size_t)k0_ * 64 + (32 * db) * 32 + 16 * s), (LAS unsigned*)(d_ + (4 + 2 * db + s) * 1024), 16, 0, 0); } while (0)
    SB_DMA(qi, 0);
    for (int kt = qi; ; --kt) {
        bf16x8 kf[4], vf[2][2];
        asm volatile("s_waitcnt vmcnt(0)" ::: "memory");
        { LAS unsigned char* rb = wbuf + cur * 8192;
#pragma unroll
          for (int d0 = 0; d0 < 4; ++d0) kf[d0] = *(const LAS bf16x8*)(rb + d0 * 1024);
#pragma unroll
          for (int db = 0; db < 2; ++db)
#pragma unroll
              for (int s = 0; s < 2; ++s) vf[db][s] = *(const LAS bf16x8*)(rb + (4 + 2 * db + s) * 1024); }
        asm volatile("s_waitcnt lgkmcnt(0)" ::: "memory");
        SB_DMA((kt > 0 ? kt - 1 : 0), cur ^ 1);
        cur ^= 1;
        f32x16 acc;
#pragma unroll
        for (int i = 0; i < 16; ++i) acc[i] = 0.f;
#pragma unroll
        for (int d0 = 0; d0 < 4; ++d0) acc = MFMA32(kf[d0], qf[d0], acc);
        const bool diag = (kt == qi);
        float w[16];
        float mx = fmaxf(acc[0], acc[1]);
#pragma unroll
        for (int i = 2; i < 16; ++i) mx = fmaxf(mx, acc[i]);
        if (!__any(mx > 15.0f)) {
            float t[16], pi[16];
#pragma unroll
            for (int i = 0; i < 16; ++i) {
                const int kl = 16 * (i >> 3) + 8 * hh + (i & 7);
                const float tv = __builtin_amdgcn_exp2f(acc[i]);
                t[i] = (diag && !(kl < r)) ? 0.f : tv;
            }
            pi[7] = 1.0f + t[7]; pi[15] = 1.0f + t[15];
#pragma unroll
            for (int i = 6; i >= 0; --i) { pi[i] = fmaf(t[i], pi[i + 1], pi[i + 1]); pi[8 + i] = fmaf(t[8 + i], pi[9 + i], pi[9 + i]); }
            const float G0 = -__builtin_amdgcn_logf(pi[0]), G1 = -__builtin_amdgcn_logf(pi[8]);
            const float P0 = __shfl_xor(G0, 32), P1 = __shfl_xor(G1, 32);
            const float F1 = __builtin_amdgcn_exp2f(R + (hh == 0 ? P1 : 0.f));
            const float F0 = __builtin_amdgcn_exp2f(R + G1 + P1 + (hh == 0 ? P0 : 0.f));
#pragma unroll
            for (int i = 0; i < 8; ++i) { w[i] = (t[i] * F0) * __builtin_amdgcn_rcpf(pi[i]); w[8 + i] = (t[8 + i] * F1) * __builtin_amdgcn_rcpf(pi[8 + i]); }
            R += (G0 + P0) + (G1 + P1);
        } else {
            float l[16], e[16];
#pragma unroll
            for (int i = 0; i < 16; ++i) {
                const int kl = 16 * (i >> 3) + 8 * hh + (i & 7);
                const float zz = acc[i];
                const float sp = fmaxf(zz, 0.f) + __builtin_amdgcn_logf(1.0f + __builtin_amdgcn_exp2f(-fabsf(zz)));
                const bool valid = (!diag) || (kl < r);
                l[i] = valid ? -sp : 0.f;
                e[i] = valid ? (zz - sp) : -1.0e30f;
            }
            float G0 = 0.f, G1 = 0.f;
#pragma unroll
            for (int i = 0; i < 8; ++i) { G0 += l[i]; G1 += l[8 + i]; }
            const float P0 = __shfl_xor(G0, 32), P1 = __shfl_xor(G1, 32);
            const float base1 = R + (hh == 0 ? P1 : 0.f);
            const float base0 = R + G1 + P1 + (hh == 0 ? P0 : 0.f);
            { float run = 0.f;
#pragma unroll
              for (int i = 7; i >= 0; --i) { w[i] = __builtin_amdgcn_exp2f(e[i] + base0 + run); run += l[i]; } }
            { float run = 0.f;
#pragma unroll
              for (int i = 7; i >= 0; --i) { w[8 + i] = __builtin_amdgcn_exp2f(e[8 + i] + base1 + run); run += l[8 + i]; } }
            R += (G0 + P0) + (G1 + P1);
        }
        u32x4 p0, p1;
        p0.x = cvtpk(w[0], w[1]); p0.y = cvtpk(w[2], w[3]); p0.z = cvtpk(w[4], w[5]); p0.w = cvtpk(w[6], w[7]);
        p1.x = cvtpk(w[8], w[9]); p1.y = cvtpk(w[10], w[11]); p1.z = cvtpk(w[12], w[13]); p1.w = cvtpk(w[14], w[15]);
        const bf16x8 pf0 = __builtin_bit_cast(bf16x8, p0), pf1 = __builtin_bit_cast(bf16x8, p1);
        o0 = MFMA32(vf[0][0], pf0, o0); o0 = MFMA32(vf[0][1], pf1, o0);
        o1 = MFMA32(vf[1][0], pf0, o1); o1 = MFMA32(vf[1][1], pf1, o1);
        if (kt == 0 || __all(R < -151.0f)) break;
    }
#undef SB_DMA
    bf16_t* op = MIX + (tq + r) * D + h * 64 + 4 * hh;
#pragma unroll
    for (int g = 0; g < 4; ++g) {
        u32x2 a; a.x = cvtpk(o0[4 * g], o0[4 * g + 1]); a.y = cvtpk(o0[4 * g + 2], o0[4 * g + 3]);
        u32x2 c; c.x = cvtpk(o1[4 * g], o1[4 * g + 1]); c.y = cvtpk(o1[4 * g + 2], o1[4 * g + 3]);
        *(u32x2*)(op + 8 * g) = a; *(u32x2*)(op + 32 + 8 * g) = c;
    }
}

__device__ __forceinline__ void gla_a_unit(const bf16_t* GK, const bf16_t* GV, const bf16_t* GF, const float* w_fg2, const float* b_fg2, float* KV, float* DEC, int w, int lane) {
    const int jh = w & 1, h = (w >> 1) & 3, n = (w >> 3) & 127, b = w >> 10;
    const int un = (b * 128 + n) * 4 + h;
    const int r = lane & 31, hh = lane >> 5, j = 32 * jh + r;
    const int pr = (r & 0x13) | ((r & 4) << 1) | ((r & 8) >> 1);
    const size_t tb = (size_t)b * SEQ + (size_t)n * 64 + 8 * hh;
    const bf16_t* kp = GK + ((size_t)((b * 4 + h) * 128 + n) * 64 + j) * 64 + 8 * hh;
    const float bias = b_fg2[h * 64 + j];
    f32x16 xa[2];
    { const float* wp = w_fg2 + (size_t)(8 * hh) * 256 + h * 64 + j;
      u32x4 wb; wb.x = cvtpk(wp[0], wp[256]); wb.y = cvtpk(wp[512], wp[768]); wb.z = cvtpk(wp[1024], wp[1280]); wb.w = cvtpk(wp[1536], wp[1792]);
      const bf16x8 wf = __builtin_bit_cast(bf16x8, wb);
      const bf16_t* gfp = GF + ((size_t)b * SEQ + (size_t)n * 64 + pr) * 16 + 8 * hh;
#pragma unroll
      for (int blk = 0; blk < 2; ++blk) {
          const bf16x8 ga = *(const bf16x8*)(gfp + (size_t)(32 * blk) * 16);
#pragma unroll
          for (int i = 0; i < 16; ++i) xa[blk][i] = 0.f;
          xa[blk] = MFMA32(ga, wf, xa[blk]);
      } }
    float la[4][8], kk[4][8];
#pragma unroll
    for (int s = 0; s < 4; ++s) {
        const u32x4 kw = *(const u32x4*)(kp + 16 * s);
#pragma unroll
        for (int q = 0; q < 4; ++q) {
            kk[s][2 * q] = bflo(kw[q]); kk[s][2 * q + 1] = bfhi(kw[q]);
            const float x0 = xa[s >> 1][8 * (s & 1) + 2 * q] + bias, x1 = xa[s >> 1][8 * (s & 1) + 2 * q + 1] + bias;
            la[s][2 * q] = (fminf(x0, 0.f) - __logf(1.0f + __expf(-fabsf(x0)))) * (1.0f / 16.0f);
            la[s][2 * q + 1] = (fminf(x1, 0.f) - __logf(1.0f + __expf(-fabsf(x1)))) * (1.0f / 16.0f);
        }
    }
    float G[4], P[4];
#pragma unroll
    for (int s = 0; s < 4; ++s) { float g = 0.f;
#pragma unroll
        for (int e = 0; e < 8; ++e) g += la[s][e];
        G[s] = g; P[s] = __shfl_xor(g, 32); }
    bf16x8 kd[4];
    float after = 0.f;
#pragma unroll
    for (int s = 3; s >= 0; --s) {
        const float a0 = after + (hh == 0 ? P[s] : 0.f);
        float run = 0.f; float dv[8];
#pragma unroll
        for (int e = 7; e >= 0; --e) { dv[e] = kk[s][e] * __expf(a0 + run); run += la[s][e]; }
        u32x4 pk; pk.x = cvtpk(dv[0], dv[1]); pk.y = cvtpk(dv[2], dv[3]); pk.z = cvtpk(dv[4], dv[5]); pk.w = cvtpk(dv[6], dv[7]);
        kd[s] = __builtin_bit_cast(bf16x8, pk);
        after += G[s] + P[s];
    }
    if (hh == 0) DEC[(size_t)un * 64 + j] = __expf(after);
    const bf16_t* vp = GV + ((size_t)((b * 4 + h) * 128 + n) * 128 + r) * 64 + 8 * hh;
    float* kvo = KV + (size_t)un * 8192 + j;
#pragma unroll
    for (int vb = 0; vb < 4; ++vb) {
        f32x16 acc;
#pragma unroll
        for (int i = 0; i < 16; ++i) acc[i] = 0.f;
#pragma unroll
        for (int s = 0; s < 4; ++s) { const bf16x8 a = *(const bf16x8*)(vp + (size_t)(32 * vb) * 64 + 16 * s); acc = MFMA32(a, kd[s], acc); }
#pragma unroll
        for (int i = 0; i < 16; ++i) kvo[(size_t)(32 * vb + crow(i, hh)) * 64] = acc[i];
    }
}

__device__ __forceinline__ void gla_c_unit(const bf16_t* GQ, const bf16_t* GG, const bf16_t* SB, const float* g_gla, bf16_t* MIX, int w, int lane) {
    const int th = w & 1, h = (w >> 1) & 3, n = (w >> 3) & 127, b = w >> 10;
    const int un = (b * 128 + n) * 4 + h;
    const int r = lane & 31, hh = lane >> 5;
    const size_t tl = (size_t)n * 64 + 32 * th + r, tok = (size_t)b * SEQ + tl;
    bf16x8 qf[4];
#pragma unroll
    for (int ks = 0; ks < 4; ++ks) qf[ks] = *(const bf16x8*)(GQ + ((size_t)(b * 4 + h) * SEQ + tl) * 64 + 16 * ks + 8 * hh);
    const bf16_t* sp = SB + (size_t)un * 8192 + (size_t)r * 64 + 8 * hh;
    const bf16_t* gp = GG + ((size_t)(b * 4 + h) * SEQ + tl) * 128 + 4 * hh;
    u32x2 gwv[4][4];
#pragma unroll
    for (int vb = 0; vb < 4; ++vb)
#pragma unroll
        for (int g = 0; g < 4; ++g) gwv[vb][g] = *(const u32x2*)(gp + 32 * vb + 8 * g);
    __builtin_amdgcn_sched_barrier(0);
    f32x16 acc[4];
    float ss = 0.f;
#pragma unroll
    for (int vb = 0; vb < 4; ++vb) {
#pragma unroll
        for (int i = 0; i < 16; ++i) acc[vb][i] = 0.f;
#pragma unroll
        for (int ks = 0; ks < 4; ++ks) { const bf16x8 a = *(const bf16x8*)(sp + (size_t)(32 * vb) * 64 + 16 * ks); acc[vb] = MFMA32(a, qf[ks], acc[vb]); }
#pragma unroll
        for (int i = 0; i < 16; ++i) ss += acc[vb][i] * acc[vb][i];
    }
    ss += __shfl_xor(ss, 32);
    const float rinv = 0.125f * __builtin_amdgcn_rsqf(ss * (1.0f / (64.0f * 128.0f)) + EPS);
    bf16_t* op = MIX + tok * D + 512 + h * 128 + 4 * hh;
    const float* gg = g_gla + h * 128 + 4 * hh;
#pragma unroll
    for (int vb = 0; vb < 4; ++vb)
#pragma unroll
        for (int g = 0; g < 4; ++g) {
            const int v0 = 32 * vb + 8 * g;
            const u32x2 gw2 = gwv[vb][g];
            const f32x4 gn = *(const f32x4*)(gg + v0);
            float gt[4] = {bflo(gw2.x), bfhi(gw2.x), bflo(gw2.y), bfhi(gw2.y)};
            float ov[4];
#pragma unroll
            for (int q = 0; q < 4; ++q) { const float y = acc[vb][4 * g + q] * rinv * gn[q]; ov[q] = y * (gt[q] * __builtin_amdgcn_rcpf(1.0f + __expf(-gt[q]))); }
            u32x2 st; st.x = cvtpk(ov[0], ov[1]); st.y = cvtpk(ov[2], ov[3]);
            *(u32x2*)(op + v0) = st;
        }
}

__global__ void __launch_bounds__(512, 2) fwd_megakernel(Params p) {
    extern __shared__ __attribute__((aligned(16))) unsigned char lds[];
    cg::grid_group grid = cg::this_grid();
    const int tid = threadIdx.x, lane = tid & 63, wave = __builtin_amdgcn_readfirstlane(tid >> 6);
    const int G = gridDim.x, bid = blockIdx.x;
    const int gw = bid * 8 + wave, NGW = G * 8;
    const int vcu = (G % 8 == 0) ? (bid % 8) * (G / 8) + bid / 8 : bid;
    const int gwx = vcu * 8 + wave;
    const int gtid = bid * 512 + tid, NTH = G * 512;
    unsigned char* ws = p.ws;
    float* MOD = (float*)(ws + WS_MOD);
    bf16_t* WDOWN = (bf16_t*)(ws + WS_WDOWN); bf16_t* HALO = (bf16_t*)(ws + WS_HALO); bf16_t* HEAD = (bf16_t*)(ws + WS_HEAD);
    bf16_t* WINM = (bf16_t*)(ws + WS_WINM); bf16_t* WINT = (bf16_t*)(ws + WS_WINT); bf16_t* WOUT = (bf16_t*)(ws + WS_WOUT); bf16_t* WUP = (bf16_t*)(ws + WS_WUP);
    float* DEC = (float*)(ws + WS_DEC); bf16_t* HB = (bf16_t*)(ws + WS_H); bf16_t* MIX = (bf16_t*)(ws + WS_MIX);
    bf16_t* SQ = (bf16_t*)(ws + WS_SQ); bf16_t* SK = (bf16_t*)(ws + WS_SK); bf16_t* SV = (bf16_t*)(ws + WS_SV); bf16_t* GQB = (bf16_t*)(ws + WS_GQ);
    bf16_t* GGB = (bf16_t*)(ws + WS_GG); bf16_t* GKB = (bf16_t*)(ws + WS_GK); bf16_t* GVB = (bf16_t*)(ws + WS_GV); float* KV = (float*)(ws + WS_KV); bf16_t* SB = (bf16_t*)(ws + WS_S);
    bf16_t* AB = (bf16_t*)(ws + WS_A);
    bf16_t* GF = (bf16_t*)(ws + WS_GF); bf16_t* WGF = (bf16_t*)(ws + WS_WGF);
    LAS unsigned char* ldsl = (LAS unsigned char*)lds;
    unsigned* BARW = (unsigned*)(ws + WS_BAR);
    volatile LAS unsigned* bst = (volatile LAS unsigned*)(ldsl + 131072 + 512);
    if (tid < 8) bst[tid] = 0u;
    const XcdBarrier xbar = xcd_barrier_post(BARW, bst);
    const XcdBarrier xbar2 = xcd_barrier_post((unsigned*)(ws + WS_BAR2), bst + 2);
    if (p.ws == nullptr) grid.sync();

    if (bid < 192) {
        float* sc = (float*)lds; float* red = sc + 2048;
        const int c4 = tid & 7, kg = tid >> 3;
        const f32x4* wp = (const f32x4*)(p.w_ada + bid * 32) + c4;
        f32x4 wv[16];
#pragma unroll
        for (int i = 0; i < 16; ++i) wv[i] = __builtin_nontemporal_load(wp + (size_t)(kg + 64 * i) * (NMOD / 4));
        for (int i = tid; i < 2048; i += 512) { const float v = p.c[i]; sc[i] = v * __builtin_amdgcn_rcpf(1.0f + __expf(-v)); }
        __syncthreads();
        f32x4 a0 = {0.f, 0.f, 0.f, 0.f}, a1 = {0.f, 0.f, 0.f, 0.f};
#pragma unroll
        for (int i = 0; i < 16; ++i) { const int k = kg + 64 * i; a0 += wv[i] * sc[k]; a1 += wv[i] * sc[1024 + k]; }
#pragma unroll
        for (int q = 0; q < 4; ++q) { red[kg * 64 + 4 * c4 + q] = a0[q]; red[kg * 64 + 32 + 4 * c4 + q] = a1[q]; }
        __syncthreads();
        if (tid < 64) { float sm = 0.f;
#pragma unroll 16
            for (int g = 0; g < 64; ++g) sm += red[g * 64 + tid];
            const int bb = tid >> 5, cc = tid & 31; MOD[bb * NMOD + bid * 32 + cc] = sm + p.b_ada[bid * 32 + cc]; }
        __syncthreads();
    }
    {
        float* scr = (float*)(lds + 32768 + wave * 8704);
        constexpr int I1 = 16 * 32, I2 = 16 * 8, I3 = 16 * 16, I4 = 16 * 16, I5 = 16 * 16, I6 = 16 * 8, I7 = 16 * 32, I8 = 16 * 176, I9 = 44 * 32;
        constexpr int NIT = I1 + I2 + I3 + I4 + I5 + I6;
        for (int it = gw; it < NIT; it += NGW) {
            int q = it;
            if (q < I1) { tr_item(p.w_in, INW, 0, WINM, D, 0, scr, q / 32, q % 32, lane); continue; } q -= I1;
            if (q < I2) { tr_item(p.w_in, INW, 1536, WINM, D, 1024, scr, q / 8, q % 8, lane); continue; } q -= I2;
            if (q < I3) { tr_item(p.w_in, INW, 2560, WINM, D, 1280, scr, q / 16, q % 16, lane); continue; } q -= I3;
            if (q < I4) { tr_item(p.w_in, INW, 1024, WINT, D, 0, scr, q / 16, q % 16, lane); continue; } q -= I4;
            if (q < I5) { tr_item(p.w_in, INW, 2048, WINT, D, 512, scr, q / 16, q % 16, lane); continue; } q -= I5;
            tr_item(p.w_in, INW, 1792, WINT, D, 1024, scr, q / 8, q % 8, lane);
        }
        for (int idx = gtid; idx < 16 * 1024; idx += NTH) { const int rr = idx & 15, k = idx >> 4; WGF[(size_t)rr * D + k] = (bf16_t)(cvtpk(p.w_in[(size_t)k * INW + 3072 + rr], 0.f) & 0xffffu); }
    }
    xcd_barrier(xbar);

    norm_mod_rows(p.x, p.g1, MOD + 0 * D, MOD + 1 * D, HB, gw, NGW, lane);
    xcd_barrier(xbar);

    for (int t16 = gw; t16 < M / 16; t16 += NGW) {
        const int fr = lane & 15, fq = lane >> 4;
        const bf16_t* ap = HB + (size_t)(t16 * 16 + fr) * D + 8 * fq;
        const bf16_t* bp = WGF + (size_t)fr * D + 8 * fq;
        f32x4 c4 = {0.f, 0.f, 0.f, 0.f};
#pragma unroll 16
        for (int kk = 0; kk < 32; ++kk) c4 = __builtin_amdgcn_mfma_f32_16x16x32_bf16(*(const bf16x8*)(ap + 32 * kk), *(const bf16x8*)(bp + 32 * kk), c4, 0, 0, 0);
#pragma unroll
        for (int i = 0; i < 4; ++i) GF[(size_t)(t16 * 16 + 4 * fq + i) * 16 + fr] = (bf16_t)(cvtpk(c4[i], 0.f) & 0xffffu);
    }
    {
        pg8::Sched2 S; S.A0 = (const char*)HB; S.B0 = (const char*)WINM; S.A1 = (const char*)WINT; S.B1 = (const char*)HB;
        S.tsA0 = S.tsB0 = S.tsA1 = S.tsB1 = (size_t)256 * D * 2;
        S.nM0 = M / 256; S.nN0 = NA / 256; S.n0 = S.nM0 * S.nN0; S.nM1 = NTR / 256; S.nN1 = M / 256; S.n1 = S.nM1 * S.nN1; S.G = G; S.c = bid;
        pg8::EpiProj E{SQ, SK, SV, GQB, GGB, GKB, GVB};
        pg8::gemm_phase<pg8::EpiProj, pg8::Sched2, true>(ldsl, D, D, S, E);
    }
    xcd_barrier(xbar);

    if (wave < 4) {
        const int gw4 = vcu * 4 + wave, NG4 = G * 4;
        for (int w = gw4; w < 2048; w += NG4) gla_a_unit(GKB, GVB, GF, p.w_fg2, p.b_fg2, KV, DEC, w, lane);
        xcd_barrier_sub4(xbar2, bst + 4, 1u, wave, lane);
        for (int e = bid * 256 + tid; e < 65536; e += G * 256) {
            const int j = e & 63, v = (e >> 6) & 127, h = (e >> 13) & 3, b = e >> 15;
            float st = 0.f;
            for (int n0 = 0; n0 < 128; n0 += 16) {
                float kvv[16], dd[16];
#pragma unroll
                for (int q = 0; q < 16; ++q) { const size_t un = (size_t)(b * 128 + n0 + q) * 4 + h; kvv[q] = KV[un * 8192 + v * 64 + j]; dd[q] = DEC[un * 64 + j]; }
#pragma unroll
                for (int q = 0; q < 16; ++q) { const size_t un = (size_t)(b * 128 + n0 + q) * 4 + h; st = dd[q] * st + kvv[q]; SB[un * 8192 + v * 64 + j] = (bf16_t)(cvtpk(st, 0.f) & 0xffffu); }
            }
        }
        xcd_barrier_sub4(xbar2, bst + 4, 2u, wave, lane);
        for (int w = gw4; w < 2048; w += NG4) gla_c_unit(GQB, GGB, SB, p.g_gla, MIX, w, lane);
    } else {
        const int gw4 = vcu * 4 + (wave - 4), NG4 = G * 4;
        for (int w = gw4; w < 4096; w += NG4) sb_unit(SQ, SK, SV, MIX, w >> 11, (w >> 8) & 7, w & 255, lane, ldsl + wave * 16384);
        asm volatile("s_waitcnt vmcnt(0)" ::: "memory");
        float* scr = (float*)(lds + wave * 16384);
        constexpr int I7 = 16 * 32, I8 = 16 * 176, I9 = 44 * 32, NCV = I7 + I8 + I9;
#define CV_DESC(q_, d_) do { int q = (q_); \
            if (q < I7) { d_ = TrDesc{p.w_out, D, 0, WOUT, D, 0, q / 32, q % 32}; } \
            else if (q < I7 + I8) { q -= I7; const int kb = q / 176, nb = q % 176, pn = nb >> 3, wi = nb & 7;     \
                d_ = TrDesc{p.w_up, FF2, (wi >> 2) * FF + pn * 128 + (wi & 3) * 32 - 32 * nb, WUP, D, 0, kb, nb}; } \
            else { q -= I7 + I8; d_ = TrDesc{p.w_down, D, 0, WDOWN, FF, 0, q / 32, q % 32}; } } while (0)
        for (int it = bid * 4 + (wave - 4); it < NCV; it += 2 * G * 4) {
            const int it1 = it + G * 4; const bool two = it1 < NCV;
            TrDesc d0, d1; CV_DESC(it, d0); CV_DESC(two ? it1 : it, d1);
            float t0[32], t1[32];
            tr_load(d0, t0, lane);
            if (two) tr_load(d1, t1, lane);
            tr_store(d0, t0, scr, lane);
            if (two) tr_store(d1, t1, scr, lane);
        }
#undef CV_DESC
    }
    xcd_barrier(xbar);

    {
        pg8::Sched2 S; S.A0 = (const char*)MIX; S.B0 = (const char*)WOUT; S.A1 = S.A0; S.B1 = S.B0;
        S.tsA0 = S.tsB0 = S.tsA1 = S.tsB1 = (size_t)256 * D * 2;
        S.nM0 = M / 256; S.nN0 = D / 256; S.n0 = S.nM0 * S.nN0; S.nM1 = 1; S.nN1 = 1; S.n1 = 0; S.G = G; S.c = bid;
        pg8::EpiResNorm<0> E{p.x, p.out, MOD + 2 * D, p.g2, MOD + 4 * D, MOD + 3 * D, HB, (float*)(ws + WS_PART0), (unsigned*)(ws + WS_CNT0), ldsl + 131072 + 1024};
        pg8::gemm_phase<pg8::EpiResNorm<0>, pg8::Sched2, true>(ldsl, D, D, S, E);
    }
    xcd_barrier(xbar);

    {
        pg8::Sched2 S; S.A0 = (const char*)HB; S.B0 = (const char*)WUP; S.A1 = S.A0; S.B1 = S.B0;
        S.tsA0 = S.tsB0 = S.tsA1 = S.tsB1 = (size_t)256 * D * 2;
        S.nM0 = M / 256; S.nN0 = FF2 / 256; S.n0 = S.nM0 * S.nN0; S.nM1 = 1; S.nN1 = 1; S.n1 = 0; S.G = G; S.c = bid;
        pg8::EpiUpConv E{AB, HALO, HEAD, p.w_conv, p.b_conv};
        pg8::gemm_phase<pg8::EpiUpConv, pg8::Sched2, true>(ldsl, D, D, S, E);
    }
    xcd_barrier(xbar);

    for (int idx = gtid; idx < 256 * 352; idx += NTH) {
        const int kb = idx / 352, f0 = (idx % 352) * 8, cv = (f0 >> 7) * 256 + (f0 & 127);
        float wv[3][8], wg[3][8], bv[8], bg[8];
#pragma unroll
        for (int jj = 0; jj < 3; ++jj)
#pragma unroll
            for (int q = 0; q < 8; ++q) { wv[jj][q] = p.w_conv[jj * FF2 + f0 + q]; wg[jj][q] = p.w_conv[jj * FF2 + FF + f0 + q]; }
#pragma unroll
        for (int q = 0; q < 8; ++q) { bv[q] = p.b_conv[f0 + q]; bg[q] = p.b_conv[FF + f0 + q]; }
        float lv[2][8], lg[2][8], hv[2][8], hg[2][8];
#pragma unroll
        for (int rr = 0; rr < 2; ++rr) {
            const bf16_t* hp = HEAD + ((size_t)kb * 2 + rr) * FF2 + cv;
            const u32x4 a = *(const u32x4*)hp, c = *(const u32x4*)(hp + 128);
#pragma unroll
            for (int q = 0; q < 4; ++q) { hv[rr][2 * q] = bflo(a[q]); hv[rr][2 * q + 1] = bfhi(a[q]); hg[rr][2 * q] = bflo(c[q]); hg[rr][2 * q + 1] = bfhi(c[q]); }
            if ((kb & 127) == 0) {
#pragma unroll
                for (int q = 0; q < 8; ++q) { lv[rr][q] = 0.f; lg[rr][q] = 0.f; }
            } else {
                const bf16_t* lp = HALO + ((size_t)(kb - 1) * 2 + rr) * FF2 + cv;
                const u32x4 a2 = *(const u32x4*)lp, c2 = *(const u32x4*)(lp + 128);
#pragma unroll
                for (int q = 0; q < 4; ++q) { lv[rr][2 * q] = bflo(a2[q]); lv[rr][2 * q + 1] = bfhi(a2[q]); lg[rr][2 * q] = bflo(c2[q]); lg[rr][2 * q + 1] = bfhi(c2[q]); }
            }
        }
        float o0[8], o1[8];
#pragma unroll
        for (int q = 0; q < 8; ++q) {
            const float va = bv[q] + wv[0][q] * lv[0][q] + wv[1][q] * lv[1][q] + wv[2][q] * hv[0][q];
            const float ga = bg[q] + wg[0][q] * lg[0][q] + wg[1][q] * lg[1][q] + wg[2][q] * hg[0][q];
            const float vb = bv[q] + wv[0][q] * lv[1][q] + wv[1][q] * hv[0][q] + wv[2][q] * hv[1][q];
            const float gb = bg[q] + wg[0][q] * lg[1][q] + wg[1][q] * hg[0][q] + wg[2][q] * hg[1][q];
            o0[q] = va * (ga * __builtin_amdgcn_rcpf(1.0f + __expf(-ga))); o1[q] = vb * (gb * __builtin_amdgcn_rcpf(1.0f + __expf(-gb)));
        }
        u32x4 s0, s1; s0.x = cvtpk(o0[0], o0[1]); s0.y = cvtpk(o0[2], o0[3]); s0.z = cvtpk(o0[4], o0[5]); s0.w = cvtpk(o0[6], o0[7]);
        s1.x = cvtpk(o1[0], o1[1]); s1.y = cvtpk(o1[2], o1[3]); s1.z = cvtpk(o1[4], o1[5]); s1.w = cvtpk(o1[6], o1[7]);
        *(u32x4*)(AB + (size_t)(kb * 64) * FF + f0) = s0;
        *(u32x4*)(AB + (size_t)(kb * 64 + 1) * FF + f0) = s1;
    }
    xcd_barrier(xbar);

    {
        pg8::Sched2 S; S.A0 = (const char*)AB; S.B0 = (const char*)WDOWN; S.A1 = S.A0; S.B1 = S.B0;
        S.tsA0 = S.tsA1 = (size_t)256 * FF * 2; S.tsB0 = S.tsB1 = (size_t)256 * FF * 2;
        S.nM0 = M / 256; S.nN0 = D / 256; S.n0 = S.nM0 * S.nN0; S.nM1 = 1; S.nN1 = 1; S.n1 = 0; S.G = G; S.c = bid;
        pg8::EpiResNorm<1> E{p.out, p.out, MOD + 5 * D, p.g_final, nullptr, nullptr, nullptr, (float*)(ws + WS_PART1), (unsigned*)(ws + WS_CNT1), ldsl + 131072 + 1024};
        pg8::gemm_phase<pg8::EpiResNorm<1>, pg8::Sched2, true>(ldsl, FF, FF, S, E);
    }

}

extern "C" void kernel_launch(void* const* d_in, const int* in_sizes, int n_in, void* d_out, int out_size, void* d_ws, size_t ws_size, hipStream_t stream) {
    static int grid = 0;
    if (grid == 0) {
        if (n_in != 16 || in_sizes[0] != M * D || out_size != M * D || ws_size < WS_END) { fprintf(stderr, "kernel_launch: unexpected shapes (n_in %d, ws %zu)\n", n_in, ws_size); grid = -1; return; }
        int dev = 0, cus = 0, per_cu = 0;
        hipGetDevice(&dev);
        hipDeviceGetAttribute(&cus, hipDeviceAttributeMultiprocessorCount, dev);
        if (hipFuncSetAttribute((const void*)fwd_megakernel, hipFuncAttributeMaxDynamicSharedMemorySize, LDS_BYTES) != hipSuccess) { fprintf(stderr, "kernel_launch: hipFuncSetAttribute failed\n"); grid = -1; return; }
        if (hipOccupancyMaxActiveBlocksPerMultiprocessor(&per_cu, (const void*)fwd_megakernel, 512, LDS_BYTES) != hipSuccess || per_cu < 1) { fprintf(stderr, "kernel_launch: occupancy query says %d\n", per_cu); per_cu = 1; }
        (void)hipGetLastError();
        grid = cus;
    }
    if (grid < 0) return;
    Params p{};
    p.x = (const float*)d_in[0]; p.c = (const float*)d_in[1]; p.w_ada = (const float*)d_in[2]; p.b_ada = (const float*)d_in[3]; p.g1 = (const float*)d_in[4];
    p.w_in = (const float*)d_in[5]; p.w_fg2 = (const float*)d_in[6]; p.b_fg2 = (const float*)d_in[7]; p.g_gla = (const float*)d_in[8]; p.w_out = (const float*)d_in[9];
    p.g2 = (const float*)d_in[10]; p.w_up = (const float*)d_in[11]; p.w_conv = (const float*)d_in[12]; p.b_conv = (const float*)d_in[13]; p.w_down = (const float*)d_in[14];
    p.g_final = (const float*)d_in[15]; p.out = (float*)d_out; p.ws = (unsigned char*)d_ws;
    if (hipMemsetAsync((char*)d_ws + WS_BAR, 0, WS_CTL_BYTES, stream) != hipSuccess) { fprintf(stderr, "kernel_launch: memset of barrier words failed\n"); return; }
    void* args[] = {&p};
    hipError_t e = hipLaunchCooperativeKernel((const void*)fwd_megakernel, dim3(grid), dim3(512), args, LDS_BYTES, stream);
    if (e != hipSuccess) fprintf(stderr, "cooperative launch failed: %s (grid %d)\n", hipGetErrorString(e), grid);
}
```
